# Optimizing an MI355X kernel written in HIP

```python
import jax
import jax.numpy as jnp
from jax import lax
import numpy as np


D_MODEL = 2048
BATCH = 1
SEQ = 16384
DEPTH = 1

CHUNK = 64
Q_BLOCK = 128
ROPE_THETA = 10000.0
EPS = 1e-6
MIX_WIDTH = D_MODEL
HEAD_DIM = 128
A_WIDTH = MIX_WIDTH // 2
B_WIDTH = MIX_WIDTH - A_WIDTH
A_HEADS = A_WIDTH // HEAD_DIM
B_HEADS = B_WIDTH // HEAD_DIM
IDX_HEADS = 16
IDX_DIM = 64
TOPK_MAX = 256
SPLITS = (A_WIDTH, A_WIDTH, A_WIDTH, A_WIDTH, IDX_HEADS * IDX_DIM, IDX_DIM, IDX_HEADS,
          B_WIDTH, B_WIDTH, B_WIDTH, B_WIDTH)
N_IN = sum(SPLITS)

kernel_name = 'hybrid_dsa_hgrn2_adaln_block'


def rms_norm(t, g):
    tf = t.astype(jnp.float32)
    y = tf * lax.rsqrt(jnp.mean(tf * tf, axis=-1, keepdims=True) + EPS)
    return (y * g.astype(jnp.float32)).astype(t.dtype)


def rope(t, pos):
    half = t.shape[-1] // 2
    inv_freq = ROPE_THETA ** (-jnp.arange(half, dtype=jnp.float32) / half)
    ang = pos.astype(jnp.float32)[:, :, None, None] * inv_freq
    cos, sin = jnp.cos(ang), jnp.sin(ang)
    tf = t.astype(jnp.float32)
    t1, t2 = tf[..., :half], tf[..., half:]
    return jnp.concatenate([t1 * cos - t2 * sin, t2 * cos + t1 * sin], axis=-1).astype(t.dtype)


def dsa_sparse_attention(q, k, v, q_idx, k_idx, w_idx):
    bsz, seq, n_heads, head_dim = q.shape
    n_sel = min(TOPK_MAX, seq // 4)
    key_pos = jnp.arange(seq)
    idx_scale = IDX_DIM ** -0.5
    att_scale = head_dim ** -0.5
    k_idx32 = k_idx.astype(jnp.float32)

    def one_block(blk):
        start = blk * Q_BLOCK
        qb = lax.dynamic_slice_in_dim(q, start, Q_BLOCK, axis=1)
        qib = lax.dynamic_slice_in_dim(q_idx, start, Q_BLOCK, axis=1).astype(jnp.float32)
        wb = lax.dynamic_slice_in_dim(w_idx, start, Q_BLOCK, axis=1).astype(jnp.float32)
        q_pos = start + jnp.arange(Q_BLOCK)
        limit = (q_pos // CHUNK + 1) * CHUNK
        admissible = key_pos[None, :] < limit[:, None]
        logits = jnp.einsum('bqhd,bsd->bqhs', qib, k_idx32) * idx_scale
        score = jnp.einsum('bqhs,bqh->bqs', jax.nn.relu(logits), wb)
        score = jnp.where(admissible[None], score, -jnp.inf)
        _, sel = lax.top_k(score, n_sel)
        sel_ok = sel < limit[None, :, None]
        kg = jax.vmap(lambda kk, ii: kk[ii])(k, sel)
        vg = jax.vmap(lambda vv, ii: vv[ii])(v, sel)
        s = jnp.einsum('bqhd,bqnhd->bqhn', qb, kg).astype(jnp.float32) * att_scale
        s = jnp.where(sel_ok[:, :, None, :], s, -jnp.inf)
        p = jax.nn.softmax(s, axis=-1)
        return jnp.einsum('bqhn,bqnhd->bqhd', p.astype(v.dtype), vg)

    out = lax.map(one_block, jnp.arange(seq // Q_BLOCK))
    return jnp.moveaxis(out, 0, 1).reshape(bsz, seq, n_heads, head_dim)


def hgrn2_recurrence(q, f_pre, i_in, lower_bound):
    bsz, seq, n_heads, d = q.shape
    n_chunks = seq // CHUNK

    def to_chunks(t):
        return t.astype(jnp.float32).reshape(bsz, n_chunks, CHUNK, n_heads, d).transpose(0, 3, 1, 2, 4)

    lb = lower_bound.astype(jnp.float32)[None, :, None, None, :]
    qc = jax.nn.silu(to_chunks(q))
    forget = lb + (1.0 - lb) * jax.nn.sigmoid(to_chunks(f_pre))
    kc = 1.0 - forget
    vc = to_chunks(i_in)
    b = jnp.cumsum(jnp.log(forget), axis=3)
    b_mid = b[:, :, :, CHUNK // 2 - 1:CHUNK // 2, :]
    b_last = b[:, :, :, -1:, :]
    causal = jnp.tril(jnp.ones((CHUNK, CHUNK), dtype=bool))
    a = jnp.einsum('bhncd,bhnsd->bhncs', qc * jnp.exp(b - b_mid), kc * jnp.exp(b_mid - b))
    a = jnp.where(causal, a, 0.0)
    o_intra = jnp.einsum('bhncs,bhnse->bhnce', a, vc)
    chunk_state = jnp.einsum('bhnsd,bhnse->bhnde', kc * jnp.exp(b_last - b), vc)
    chunk_decay = jnp.exp(b_last[:, :, :, 0, :])

    def step(state, inp):
        ds, dec = inp
        return state * dec[..., None] + ds, state

    _, prev = lax.scan(step, jnp.zeros((bsz, n_heads, d, d), jnp.float32),
                       (jnp.moveaxis(chunk_state, 2, 0), jnp.moveaxis(chunk_decay, 2, 0)))
    prev = jnp.moveaxis(prev, 0, 2)
    o_inter = jnp.einsum('bhncd,bhnde->bhnce', qc * jnp.exp(b), prev)
    o = (o_intra + o_inter).transpose(0, 2, 3, 1, 4).reshape(bsz, seq, n_heads, d)
    return o.astype(q.dtype)


def setup_inputs(seed: int = 0) -> dict:
    key = jax.random.key(seed)
    ks = jax.random.split(key, 14)
    x = jax.random.normal(ks[0], (BATCH, SEQ, D_MODEL), jnp.float32)
    c = jax.random.normal(ks[1], (BATCH, D_MODEL), jnp.float32)
    offset = jax.random.randint(ks[2], (BATCH, 1), 0, 4096, dtype=jnp.int32)
    positions = (offset + jnp.arange(SEQ, dtype=jnp.int32)[None, :]).astype(jnp.int32)
    ada_w = jax.random.normal(ks[3], (DEPTH, D_MODEL, 3 * D_MODEL), jnp.float32) * (0.5 * D_MODEL ** -0.5)
    ada_b = 0.02 * jax.random.normal(ks[4], (DEPTH, 3 * D_MODEL), jnp.float32)
    norm_g = 1.0 + 0.02 * jax.random.normal(ks[5], (DEPTH, D_MODEL), jnp.float32)
    w_in = jax.random.normal(ks[6], (DEPTH, D_MODEL, N_IN), jnp.float32) * D_MODEL ** -0.5
    q_norm_g = 1.0 + 0.02 * jax.random.normal(ks[7], (DEPTH, HEAD_DIM), jnp.float32)
    k_norm_g = 1.0 + 0.02 * jax.random.normal(ks[8], (DEPTH, HEAD_DIM), jnp.float32)
    idx_k_norm_g = 1.0 + 0.02 * jax.random.normal(ks[9], (DEPTH, IDX_DIM), jnp.float32)
    hgrn_lb_logits = 0.1 * jax.random.normal(ks[10], (DEPTH + 1, B_WIDTH), jnp.float32)
    hgrn_norm_g = 1.0 + 0.02 * jax.random.normal(ks[11], (DEPTH, HEAD_DIM), jnp.float32)
    w_out = jax.random.normal(ks[12], (DEPTH, MIX_WIDTH, D_MODEL), jnp.float32) * MIX_WIDTH ** -0.5
    return {'x': x, 'c': c, 'positions': positions, 'ada_w': ada_w, 'ada_b': ada_b,
            'norm_g': norm_g, 'w_in': w_in, 'q_norm_g': q_norm_g, 'k_norm_g': k_norm_g,
            'idx_k_norm_g': idx_k_norm_g, 'hgrn_lb_logits': hgrn_lb_logits,
            'hgrn_norm_g': hgrn_norm_g, 'w_out': w_out}


def reference(x, c, positions, ada_w, ada_b, norm_g, w_in, q_norm_g, k_norm_g, idx_k_norm_g,
              hgrn_lb_logits, hgrn_norm_g, w_out):
    bsz, seq, _ = x.shape
    lower_bounds = jnp.cumsum(jax.nn.softmax(hgrn_lb_logits.astype(jnp.float32), axis=0), axis=0)
    offsets = np.cumsum(SPLITS)[:-1].tolist()
    for layer in range(DEPTH):
        mod = jax.nn.silu(c) @ ada_w[layer] + ada_b[layer]
        shift, scale, gate = jnp.split(mod, 3, axis=-1)
        h = rms_norm(x, norm_g[layer]) * (1.0 + scale[:, None, :]) + shift[:, None, :]
        proj = h @ w_in[layer]
        a_q, a_k, a_v, a_g, i_q, i_k, i_w, r_q, r_f, r_i, r_g = jnp.split(proj, offsets, axis=-1)

        q = rope(rms_norm(a_q.reshape(bsz, seq, A_HEADS, HEAD_DIM), q_norm_g[layer]), positions)
        k = rope(rms_norm(a_k.reshape(bsz, seq, A_HEADS, HEAD_DIM), k_norm_g[layer]), positions)
        v = a_v.reshape(bsz, seq, A_HEADS, HEAD_DIM)
        qi = rope(i_q.reshape(bsz, seq, IDX_HEADS, IDX_DIM), positions)
        ki = rope(rms_norm(i_k, idx_k_norm_g[layer])[:, :, None, :], positions)[:, :, 0, :]
        wi = i_w * (IDX_HEADS ** -0.5)
        o_a = dsa_sparse_attention(q, k, v, qi, ki, wi).reshape(bsz, seq, A_WIDTH) * jax.nn.silu(a_g)

        lb = lower_bounds[layer].reshape(B_HEADS, HEAD_DIM)
        o_r = hgrn2_recurrence(r_q.reshape(bsz, seq, B_HEADS, HEAD_DIM),
                               r_f.reshape(bsz, seq, B_HEADS, HEAD_DIM),
                               r_i.reshape(bsz, seq, B_HEADS, HEAD_DIM), lb)
        o_r = rms_norm(o_r, hgrn_norm_g[layer]).reshape(bsz, seq, B_WIDTH) * jax.nn.silu(r_g)

        mix = jnp.concatenate([o_a, o_r], axis=-1) @ w_out[layer]
        x = x + gate[:, None, :] * mix
    return x
```

```cpp
#include <hip/hip_runtime.h>
#include <hip/hip_cooperative_groups.h>
#include <cstdio>
#include <cstdint>
#include <cmath>
#include <cstring>
namespace cg = cooperative_groups;
namespace pg8 {
#define PG8_LAS __attribute__((address_space(3)))
typedef unsigned short bf16_t;
typedef short bf16x8 __attribute__((ext_vector_type(8)));
typedef float f32x4 __attribute__((ext_vector_type(4)));
typedef unsigned u32x4 __attribute__((ext_vector_type(4)));
constexpr int BM = 256, BK = 64, HALF = 128, HTB = HALF * BK * 2  , STAGE_BYTES = 8 * HTB, NXCD = 8, WGM = 8;

__host__ __device__ __forceinline__ int lds_byte(int r, int c) { const int st = (r >> 4) * 2 + (c >> 5), rr = r & 15, cc = c & 31, ob = rr * 64 + cc * 2; return st * 1024 + (ob ^ (((ob >> 9) & 1) << 5)); }
__host__ __device__ __forceinline__ void stage_rc(int b, int& R, int& C) { const int st = b / 1024, sb = b % 1024, swz = sb ^ (((sb >> 9) & 1) << 5); R = (st >> 1) * 16 + swz / 64; C = (st & 1) * 32 + (swz % 64) / 2; }
__host__ __device__ __forceinline__ int perm32(int rho) { const int n = rho >> 4, i = rho & 15; return 8 * (i >> 2) + 4 * n + (i & 3); }

struct Unit { int pm, pn; };
struct Gemm { const bf16_t* A; const bf16_t* Bt; int M, N, K; };

struct StaticOrder {
    int nM, nN, nwg, G, c;
    __host__ __device__ void init(int M, int N, int G_, int c_) { nM = M / BM; nN = N / BM; nwg = nM * nN; G = G_; c = c_; }
    __host__ __device__ bool next(int i, Unit& u) const {
        const long L = (long)i * G + c; if (L >= nwg) return false;
        int wgid = (int)L; { const int q = nwg / NXCD, r = nwg % NXCD, xcd = wgid % NXCD, off = wgid / NXCD; wgid = (xcd < r ? xcd * (q + 1) : r * (q + 1) + (xcd - r) * q) + off; }
        const int nig = WGM * nN, gid = wgid / nig, fm = gid * WGM, gsz = (nM - fm) < WGM ? (nM - fm) : WGM;
        u.pm = fm + ((wgid % nig) % gsz); u.pn = (wgid % nig) / gsz; return true;
    }
    __device__ __forceinline__ void a_ready(const Unit&) const {}
    __device__ __forceinline__ void done(const Unit&) const {}
};

__device__ __forceinline__ unsigned cvt_pk_bf16(float lo, float hi) { unsigned r; asm volatile("v_cvt_pk_bf16_f32 %0, %1, %2" : "=v"(r) : "v"(lo), "v"(hi)); return r; }
typedef float f32x2 __attribute__((ext_vector_type(2)));
typedef float f32x2 __attribute__((ext_vector_type(2)));
struct EpiBf16 {
    static constexpr bool PERM = true, AFTER_DRAIN = false;
    bf16_t* O; int ldc;
    __device__ __forceinline__ void operator()(const f32x4 (&acc)[2][2][4][2], const Unit& u, int wr, int wc, int fr, int fq) const {
        const int row0 = u.pm * BM + wr * 64 + fr; const int col0 = u.pn * BM + wc * 32 + 8 * fq;
#pragma unroll
        for (int ai = 0; ai < 2; ++ai)
#pragma unroll
            for (int m = 0; m < 4; ++m) { bf16_t* rowp = O + (size_t)(row0 + ai * HALF + m * 16) * ldc + col0;
#pragma unroll
                for (int bj = 0; bj < 2; ++bj) { const f32x4 v0 = acc[ai][bj][m][0], v1 = acc[ai][bj][m][1];
                    u32x4 w; w.x = cvt_pk_bf16(v0[0], v0[1]); w.y = cvt_pk_bf16(v0[2], v0[3]); w.z = cvt_pk_bf16(v1[0], v1[1]); w.w = cvt_pk_bf16(v1[2], v1[3]);
                    *(u32x4*)(rowp + bj * HALF) = w; } }
    }
};
struct EpiVT {
    static constexpr bool PERM = true, AFTER_DRAIN = false;
    unsigned char* O;
    __device__ __forceinline__ void operator()(const f32x4 (&acc)[2][2][4][2], const Unit& u, int wr, int wc, int fr, int fq) const {
        const int row0 = u.pm * BM + wr * 64 + fr;
#pragma unroll
        for (int ai = 0; ai < 2; ++ai)
#pragma unroll
            for (int m = 0; m < 4; ++m) { const int R = row0 + ai * HALF + m * 16; const int hd = R >> 7, dim = R & 127;
#pragma unroll
                for (int bj = 0; bj < 2; ++bj) { const f32x4 v0 = acc[ai][bj][m][0], v1 = acc[ai][bj][m][1];
                    const int blk = u.pn * 4 + bj * 2 + (wc >> 1);
                    int t_; unsigned lo, hi;
                    t_ = __builtin_amdgcn_cvt_pk_fp8_f32(v0[0], v0[1], 0, false); t_ = __builtin_amdgcn_cvt_pk_fp8_f32(v0[2], v0[3], t_, true); lo = (unsigned)t_;
                    t_ = __builtin_amdgcn_cvt_pk_fp8_f32(v1[0], v1[1], 0, false); t_ = __builtin_amdgcn_cvt_pk_fp8_f32(v1[2], v1[3], t_, true); hi = (unsigned)t_;
                    unsigned long long w = (unsigned long long)lo | ((unsigned long long)hi << 32);
                    *(unsigned long long*)(O + ((((size_t)(hd * 256 + blk) * 4 + (dim >> 5)) * 2 + (wc & 1)) * 64 + (fq & 1) * 32 + (dim & 31)) * 16 + 8 * (fq >> 1)) = w; } }
    }
};
struct EpiProj {
    static constexpr bool PERM = true, AFTER_DRAIN = false;
    bf16_t* O; size_t stride; float* tail;
    __device__ __forceinline__ void operator()(const f32x4 (&acc)[2][2][4][2], const Unit& u, int wr, int wc, int fr, int fq) const {
        const int row0 = u.pm * BM + wr * 64 + fr; const int colt = u.pn * BM; const int t = colt >> 10;
        if (t < 5) {
            bf16_t* base = O + (size_t)t * stride; const int col0 = (colt & 1023) + wc * 32 + 8 * fq;
#pragma unroll
            for (int ai = 0; ai < 2; ++ai)
#pragma unroll
                for (int m = 0; m < 4; ++m) { bf16_t* rowp = base + (size_t)(row0 + ai * HALF + m * 16) * 1024 + col0;
#pragma unroll
                    for (int bj = 0; bj < 2; ++bj) { const f32x4 v0 = acc[ai][bj][m][0], v1 = acc[ai][bj][m][1];
                        u32x4 w; w.x = cvt_pk_bf16(v0[0], v0[1]); w.y = cvt_pk_bf16(v0[2], v0[3]); w.z = cvt_pk_bf16(v1[0], v1[1]); w.w = cvt_pk_bf16(v1[2], v1[3]);
                        *(u32x4*)(rowp + bj * HALF) = w; } }
        } else {
            const int col0 = wc * 32 + 8 * fq;
#pragma unroll
            for (int ai = 0; ai < 2; ++ai)
#pragma unroll
                for (int m = 0; m < 4; ++m) { float* rp = tail + (size_t)(row0 + ai * HALF + m * 16) * 128 + col0;
                    *(f32x4*)(rp) = acc[ai][0][m][0]; *(f32x4*)(rp + 4) = acc[ai][0][m][1]; }
        }
    }
};
struct EpiOut {
    static constexpr bool PERM = true, AFTER_DRAIN = false;
    const float* x; const float* gate; float* out; int ldc;
    __device__ __forceinline__ void operator()(const f32x4 (&acc)[2][2][4][2], const Unit& u, int wr, int wc, int fr, int fq) const {
        const int row0 = u.pm * BM + wr * 64 + fr; const int col0 = u.pn * BM + wc * 32 + 8 * fq;
        f32x4 gv[2][2];
#pragma unroll
        for (int bj = 0; bj < 2; ++bj)
#pragma unroll
            for (int n = 0; n < 2; ++n) gv[bj][n] = *(const f32x4*)(gate + col0 + bj * HALF + 4 * n);
#pragma unroll
        for (int ai = 0; ai < 2; ++ai)
#pragma unroll
            for (int m = 0; m < 4; ++m) { const size_t off = (size_t)(row0 + ai * HALF + m * 16) * ldc + col0;
#pragma unroll
                for (int bj = 0; bj < 2; ++bj)
#pragma unroll
                    for (int n = 0; n < 2; ++n) { const f32x4 xv = *(const f32x4*)(x + off + bj * HALF + 4 * n);
                        *(f32x4*)(out + off + bj * HALF + 4 * n) = xv + gv[bj][n] * acc[ai][bj][m][n]; } }
    }
};

template <class Epi, class Sched, bool ALIGN_EPI = false, bool SP2 = false>
__device__ __forceinline__ void gemm_phase(PG8_LAS unsigned char* lds, const Gemm g, const Sched& S, const Epi& E) {
    const int tid = threadIdx.x, wid = __builtin_amdgcn_readfirstlane(tid >> 6), lane = tid & 63, wr = wid >> 2, wc = wid & 3, fr = lane & 15, fq = lane >> 4;
    const int K = g.K, nt = K / BK;
    unsigned voffA[2], voffB[2];
#pragma unroll
    for (int i = 0; i < 2; ++i) { int R, C; stage_rc(tid * 16 + i * 8192, R, C); const int Rb = Epi::PERM ? ((R & ~31) + perm32(R & 31)) : R;
        voffA[i] = (unsigned)(R * K + C) * 2u; voffB[i] = (unsigned)(Rb * K + C) * 2u; }
    const size_t kstep = (size_t)(BK * 2);
    const size_t hstep = (size_t)HALF * K * 2;
    const size_t tstep = 2 * hstep;
    const unsigned ldsw = (unsigned)wid * 1024u;
    const int aoff = lds_byte(wr * 64 + fr, fq * 8), boff = lds_byte(wc * 32 + fr, fq * 8);
#define PG8_SA(b, h) (((b) * 2 + (h)) * HTB)
#define PG8_SB(b, h) ((4 + (b) * 2 + (h)) * HTB)
#define PG8_STAGE(bufoff, gbase, voff) do { _Pragma("unroll") for (int _i = 0; _i < 2; ++_i) \
        __builtin_amdgcn_global_load_lds((const unsigned*)((const char*)(gbase) + (voff)[_i]), (PG8_LAS unsigned*)(lds + (bufoff) + ldsw + _i * 8192), 16, 0, 0); } while (0)
#define PG8_LDA(dst, b, h) do { _Pragma("unroll") for (int m = 0; m < 4; ++m) _Pragma("unroll") for (int k = 0; k < 2; ++k) dst[m][k] = *(const PG8_LAS bf16x8*)(lds + PG8_SA(b, h) + aoff + m * 2048 + k * 1024); } while (0)
#define PG8_LDB(dst, b, h) do { _Pragma("unroll") for (int n = 0; n < 2; ++n) _Pragma("unroll") for (int k = 0; k < 2; ++k) dst[n][k] = *(const PG8_LAS bf16x8*)(lds + PG8_SB(b, h) + boff + n * 2048 + k * 1024); } while (0)
#define PG8_MMA(ai, bj, At, Bt) do { __builtin_amdgcn_s_setprio(1); _Pragma("unroll") for (int m = 0; m < 4; ++m) _Pragma("unroll") for (int n = 0; n < 2; ++n) _Pragma("unroll") for (int k = 0; k < 2; ++k) \
        acc[ai][bj][m][n] = __builtin_amdgcn_mfma_f32_16x16x32_bf16(Bt[n][k], At[m][k], acc[ai][bj][m][n], 0, 0, 0); __builtin_amdgcn_s_setprio(0); } while (0)
#define PG8_WAIT_V(n) asm volatile("s_waitcnt vmcnt(" #n ")" ::: "memory")
#define PG8_WAIT_L(n) asm volatile("s_waitcnt lgkmcnt(" #n ")" ::: "memory")
#define PG8_BAR __builtin_amdgcn_s_barrier()
#define PG8_SCHED __builtin_amdgcn_sched_barrier(0)
    Unit cur, nxt; int ui = 0;
    if (!S.next(0, cur)) return;
    f32x4 acc[2][2][4][2];
#pragma unroll
    for (int a = 0; a < 2; ++a)
#pragma unroll
        for (int b = 0; b < 2; ++b)
#pragma unroll
            for (int m = 0; m < 4; ++m)
#pragma unroll
                for (int n = 0; n < 2; ++n) acc[a][b][m][n] = (f32x4){0.f, 0.f, 0.f, 0.f};
    bf16x8 At[4][2], B0[2][2], B1[2][2];
    const char* cA = (const char*)g.A + (size_t)cur.pm * tstep; const char* cB = (const char*)g.Bt + (size_t)cur.pn * tstep;
    S.a_ready(cur);
    if constexpr (SP2) {
        PG8_STAGE(PG8_SB(0, 0), cB, voffB); PG8_STAGE(PG8_SB(0, 1), cB + hstep, voffB); PG8_STAGE(PG8_SA(0, 0), cA, voffA); PG8_STAGE(PG8_SA(0, 1), cA + hstep, voffA);
        if (wr == 1) PG8_BAR;
        PG8_WAIT_V(2); PG8_BAR;
        PG8_STAGE(PG8_SB(1, 0), cB + kstep, voffB); PG8_STAGE(PG8_SA(1, 0), cA + kstep, voffA); PG8_STAGE(PG8_SB(1, 1), cB + hstep + kstep, voffB);
        PG8_WAIT_V(6); PG8_BAR;
    } else {
        PG8_STAGE(PG8_SB(0, 0), cB, voffB); PG8_STAGE(PG8_SA(0, 0), cA, voffA); PG8_STAGE(PG8_SB(0, 1), cB + hstep, voffB); PG8_STAGE(PG8_SA(0, 1), cA + hstep, voffA);
        if (wr == 1) PG8_BAR;
        PG8_WAIT_V(4); PG8_BAR;
        PG8_STAGE(PG8_SB(1, 0), cB + kstep, voffB); PG8_STAGE(PG8_SA(1, 0), cA + kstep, voffA); PG8_STAGE(PG8_SB(1, 1), cB + hstep + kstep, voffB);
        PG8_WAIT_V(6); PG8_BAR;
    }
    for (;;) {
        const bool has_next = S.next(ui + 1, nxt);
        const char* nA = has_next ? (const char*)g.A + (size_t)nxt.pm * tstep : cA; const char* nB = has_next ? (const char*)g.Bt + (size_t)nxt.pn * tstep : cB;
        for (int t = 0; t < nt; t += 2) {
            const bool last = (t == nt - 2);
            const char* a1 = cA + (size_t)(t + 1) * kstep;
            const char* a2 = last ? nA : cA + (size_t)(t + 2) * kstep; const char* b2 = last ? nB : cB + (size_t)(t + 2) * kstep;
            const char* a3 = a2 + kstep; const char* b3 = b2 + kstep;
            if (last && has_next) S.a_ready(nxt);
            if constexpr (SP2) {
            PG8_LDB(B0, 0, 0); PG8_LDB(B1, 0, 1); PG8_SCHED; PG8_LDA(At, 0, 0); PG8_STAGE(PG8_SA(1, 1), a1 + hstep, voffA);
            PG8_WAIT_V(8); PG8_WAIT_L(0); PG8_BAR; PG8_MMA(0, 0, At, B0); PG8_MMA(0, 1, At, B1); PG8_BAR; PG8_SCHED;
            PG8_LDA(At, 0, 1); PG8_STAGE(PG8_SB(0, 0), b2, voffB); PG8_STAGE(PG8_SB(0, 1), b2 + hstep, voffB); PG8_STAGE(PG8_SA(0, 0), a2, voffA);
            PG8_WAIT_V(8); PG8_WAIT_L(0); PG8_BAR; PG8_MMA(1, 0, At, B0); PG8_MMA(1, 1, At, B1); PG8_BAR; PG8_SCHED;
            PG8_LDB(B0, 1, 0); PG8_LDB(B1, 1, 1); PG8_SCHED; PG8_LDA(At, 1, 0); PG8_STAGE(PG8_SA(0, 1), a2 + hstep, voffA);
            PG8_WAIT_V(8); PG8_WAIT_L(0); PG8_BAR; PG8_MMA(0, 0, At, B0); PG8_MMA(0, 1, At, B1); PG8_BAR; PG8_SCHED;
            PG8_LDA(At, 1, 1); PG8_STAGE(PG8_SB(1, 0), b3, voffB); PG8_STAGE(PG8_SB(1, 1), b3 + hstep, voffB); PG8_STAGE(PG8_SA(1, 0), a3, voffA);
            PG8_WAIT_V(8); PG8_WAIT_L(0); PG8_BAR; PG8_MMA(1, 0, At, B0); PG8_MMA(1, 1, At, B1); PG8_BAR; PG8_SCHED;
            } else {
            PG8_LDB(B0, 0, 0); PG8_SCHED; PG8_LDA(At, 0, 0); PG8_STAGE(PG8_SA(1, 1), a1 + hstep, voffA);
            PG8_WAIT_L(8); PG8_BAR; PG8_WAIT_L(0); PG8_MMA(0, 0, At, B0); PG8_BAR; PG8_SCHED;
            PG8_LDB(B1, 0, 1); PG8_STAGE(PG8_SB(0, 0), b2, voffB);
            PG8_BAR; PG8_WAIT_L(0); PG8_MMA(0, 1, At, B1); PG8_BAR;
            PG8_LDA(At, 0, 1); PG8_STAGE(PG8_SA(0, 0), a2, voffA);
            PG8_BAR; PG8_WAIT_L(0); PG8_MMA(1, 0, At, B0); PG8_BAR; PG8_SCHED;
            PG8_STAGE(PG8_SB(0, 1), b2 + hstep, voffB);
            PG8_WAIT_V(6); PG8_BAR; PG8_MMA(1, 1, At, B1); PG8_BAR;
            PG8_LDB(B0, 1, 0); PG8_SCHED; PG8_LDA(At, 1, 0); PG8_STAGE(PG8_SA(0, 1), a2 + hstep, voffA);
            PG8_WAIT_L(8); PG8_BAR; PG8_WAIT_L(0); PG8_MMA(0, 0, At, B0); PG8_BAR; PG8_SCHED;
            PG8_LDB(B1, 1, 1); PG8_STAGE(PG8_SB(1, 0), b3, voffB);
            PG8_BAR; PG8_WAIT_L(0); PG8_MMA(0, 1, At, B1); PG8_BAR;
            PG8_LDA(At, 1, 1); PG8_STAGE(PG8_SA(1, 0), a3, voffA);
            PG8_BAR; PG8_WAIT_L(0); PG8_MMA(1, 0, At, B0); PG8_BAR; PG8_SCHED;
            PG8_STAGE(PG8_SB(1, 1), b3 + hstep, voffB);
            PG8_WAIT_V(6); PG8_BAR; PG8_MMA(1, 1, At, B1); PG8_BAR;
            }
        }
        if constexpr (ALIGN_EPI) { if (wr == 0) PG8_BAR; }
        if constexpr (!Epi::AFTER_DRAIN) { E(acc, cur, wr, wc, fr, fq); S.done(cur); }
        if (!has_next) break;
#pragma unroll
        for (int a = 0; a < 2; ++a)
#pragma unroll
            for (int b = 0; b < 2; ++b)
#pragma unroll
                for (int m = 0; m < 4; ++m)
#pragma unroll
                    for (int n = 0; n < 2; ++n) acc[a][b][m][n] = (f32x4){0.f, 0.f, 0.f, 0.f};
        cur = nxt; cA = nA; cB = nB; ++ui;
        if constexpr (ALIGN_EPI) { if (wr == 1) PG8_BAR; }
    }
    PG8_WAIT_V(0);
    if constexpr (!ALIGN_EPI) { if (wr == 0) PG8_BAR; }
    PG8_BAR;
    if constexpr (Epi::AFTER_DRAIN) { E.fused(acc, cur, wr, wc, fr, fq, lds, wid, lane); S.done(cur); }
#undef PG8_SA
#undef PG8_SB
#undef PG8_STAGE
#undef PG8_LDA
#undef PG8_LDB
#undef PG8_MMA
#undef PG8_WAIT_V
#undef PG8_WAIT_L
#undef PG8_BAR
#undef PG8_SCHED
}
}

constexpr int NWAVES = 8, NTHR = NWAVES * 64;
constexpr int SEQ = 16384, DM = 2048, HD = 128, AH = 8, BH = 8, IH = 16, ID = 64, NIN = 9296;
constexpr int NPROJ = 5376;
constexpr int NWROWS = NPROJ;
#ifndef FP8_HG
#define FP8_HG 2
#endif
constexpr int N8 = 4096 + (FP8_HG ? 1024 : 0);
constexpr float EPS = 1e-6f;
#ifndef MK_N_LAUNCHES
#define MK_N_LAUNCHES 1
#endif
constexpr int N_PHASES = 7;
#ifndef IXP_SCORE
#define IXP_SCORE 1
#endif
#ifndef IXP_TAIL
#define IXP_TAIL 1
#endif
#ifndef IXP_ATOM2
#define IXP_ATOM2 0
#endif
#ifndef REP_GEMM
#define REP_GEMM 1
#endif
#ifndef REP_IDX
#define REP_IDX 1
#endif
#ifndef REP_ATT
#define REP_ATT 1
#endif
#ifndef REP_HG
#define REP_HG 1
#endif
#ifndef REP_P0
#define REP_P0 1
#endif
#ifndef REP_OUT
#define REP_OUT 1
#endif
#ifndef REP_P01
#define REP_P01 1
#endif

constexpr size_t MiB = 1u << 20;
constexpr size_t WS_CTL = 0, CTL_ZERO_BYTES = 64 * 1024;
constexpr size_t WS_WIN = 1 * MiB;
constexpr size_t WS_WOUT = 39 * MiB;
constexpr size_t WS_H = 47 * MiB;
constexpr size_t WS_PROJ = 111 * MiB;
constexpr size_t PROJ_STRIDE = 32 * MiB;
constexpr size_t WS_TAIL = 367 * MiB;
constexpr size_t WS_VT = 375 * MiB;
constexpr size_t WS_MASK = 407 * MiB;
constexpr size_t WS_IKB = 439 * MiB;
constexpr size_t WS_GS = 441 * MiB;
constexpr size_t WS_GD = 457 * MiB;
constexpr size_t WS_KF = 391 * MiB;
constexpr size_t WS_H8 = 458 * MiB;
constexpr size_t WS_STAT = 490 * MiB;
constexpr size_t WS_W8 = 491 * MiB;
constexpr size_t WS_END = 503 * MiB;
enum { PB_Q = 0, PB_K = 1, PB_AG = 2, PB_QI = 3, PB_RQ = 4, PB_RF = 5, PB_RI = 6, PB_RG = 7 };

constexpr int LDS_BYTES = 157696;
constexpr int LDS_BARST = LDS_BYTES - 64;
constexpr size_t CTL_BAR_OFF = 32768;

#define LAS __attribute__((address_space(3)))
typedef unsigned short bf16;
typedef unsigned v4u __attribute__((ext_vector_type(4)));
typedef unsigned v2u __attribute__((ext_vector_type(2)));
typedef float f32x4 __attribute__((ext_vector_type(4)));
typedef float f32x16 __attribute__((ext_vector_type(16)));
typedef short bf16x8 __attribute__((ext_vector_type(8)));

__device__ __forceinline__ unsigned f2bf(float f) { unsigned u = __builtin_bit_cast(unsigned, f); return (u + 0x7fffu + ((u >> 16) & 1u)) >> 16; }
typedef float f32x2_t __attribute__((ext_vector_type(2))); typedef __bf16 bf16x2_t __attribute__((ext_vector_type(2)));
__device__ __forceinline__ unsigned pk2(float lo, float hi) { f32x2_t v = {lo, hi}; bf16x2_t b = __builtin_convertvector(v, bf16x2_t); return __builtin_bit_cast(unsigned, b); }
__device__ __forceinline__ float bflo(unsigned w) { return __builtin_bit_cast(float, w << 16); }
__device__ __forceinline__ float bfhi(unsigned w) { return __builtin_bit_cast(float, w & 0xffff0000u); }
__device__ __forceinline__ float wave_sum(float v) {
#pragma unroll
    for (int o = 1; o < 64; o <<= 1) v += __shfl_xor(v, o);
    return v;
}
__device__ __forceinline__ float relu1(float x) { const int xi = __builtin_bit_cast(int, x); return __builtin_bit_cast(float, xi > 0 ? xi : 0); }
__device__ __forceinline__ float sigmoidf_(float x) { return __builtin_amdgcn_rcpf(1.0f + __expf(-x)); }
__device__ __forceinline__ float siluf_(float x) { return x * __builtin_amdgcn_rcpf(1.0f + __expf(-x)); }
__device__ __forceinline__ void unpack8(const v4u w, float (&f)[8]) {
    f[0] = bflo(w.x); f[1] = bfhi(w.x); f[2] = bflo(w.y); f[3] = bfhi(w.y); f[4] = bflo(w.z); f[5] = bfhi(w.z); f[6] = bflo(w.w); f[7] = bfhi(w.w);
}
__device__ __forceinline__ v4u pack8(const float (&f)[8]) { v4u w; w.x = pk2(f[0], f[1]); w.y = pk2(f[2], f[3]); w.z = pk2(f[4], f[5]); w.w = pk2(f[6], f[7]); return w; }

struct Args {
    const float* x; const float* c; const int* pos; const float* ada_w; const float* ada_b; const float* norm_g; const float* w_in;
    const float* q_norm_g; const float* k_norm_g; const float* ik_norm_g; const float* lb_logits; const float* hgrn_norm_g; const float* w_out;
    float* out; unsigned char* ws;
    float invf_a[64]; float invf_i[32];
    int ph_lo, ph_hi, bar_region, pad0;
};

__device__ __forceinline__ void transpose_item(const float* W, int N, int K, int ocol0, int nvalid, bf16* WT, int drow0, LAS float* scr, int k0, int lane) {
#pragma unroll 8
    for (int i = 0; i < 32; ++i) { const int kk = 2 * i + (lane >> 5), cc = lane & 31;
        scr[kk * 33 + cc] = (cc < nvalid) ? W[(size_t)(k0 + kk) * N + ocol0 + cc] : 0.f; }
    asm volatile("s_waitcnt lgkmcnt(0)" ::: "memory");
    const int c = lane & 7;
#pragma unroll
    for (int j = 0; j < 4; ++j) { const int n = (lane >> 3) + 8 * j; const LAS float* s = scr + (8 * c) * 33 + n;
        v4u o; o.x = pk2(s[0 * 33], s[1 * 33]); o.y = pk2(s[2 * 33], s[3 * 33]); o.z = pk2(s[4 * 33], s[5 * 33]); o.w = pk2(s[6 * 33], s[7 * 33]);
        *(v4u*)(WT + (size_t)(drow0 + n) * K + k0 + 8 * c) = o; }
    asm volatile("s_waitcnt lgkmcnt(0)" ::: "memory");
}
__device__ __forceinline__ void phase0(const Args& a, LAS unsigned char* lds, int tid, int wave, int lane, bool do_gemv) {
    bf16* WIN = (bf16*)(a.ws + WS_WIN); bf16* WOUT = (bf16*)(a.ws + WS_WOUT);
    LAS float* scr = (LAS float*)(lds + wave * 8704);
    const int gw = blockIdx.x * NWAVES + wave, NGW = gridDim.x * NWAVES;
    constexpr int I_IN = (NWROWS / 32) * (DM / 64), I_OUT = (DM / 32) * (DM / 64), I_8 = (N8 / 32) * (DM / 64);
    unsigned char* W8 = (unsigned char*)(a.ws + WS_W8);
    auto decode = [&](int it, const float*& src, int& N, int& nv, int& kind, int& drow0, int& k0) {
        if (it < I_IN) { const int nb = it % (NWROWS / 32), kb = it / (NWROWS / 32); const int d0 = nb * 32; int o; nv = 32;
            if (d0 < 1024) o = 4096 + d0; else if (d0 < 5120) o = 5200 + (d0 - 1024);
            else { const int rel = d0 - 5120; o = 5120 + rel; nv = 80 - rel; nv = nv < 0 ? 0 : (nv > 32 ? 32 : nv); if (nv == 0) o = 0; }
            kind = 0; N = NIN; drow0 = d0; k0 = kb * 64; src = a.w_in + (size_t)k0 * NIN + o;
        } else if (it < I_IN + I_OUT) { const int r = it - I_IN; const int nb = r % (DM / 32), kb = r / (DM / 32);
            kind = 1; N = DM; nv = 32; drow0 = nb * 32; k0 = kb * 64; src = a.w_out + (size_t)k0 * DM + nb * 32;
        } else { const int r = it - I_IN - I_OUT; const int nb = r % (N8 / 32), kb = r / (N8 / 32);
            kind = 2; N = NIN; nv = 32; drow0 = nb * 32; k0 = kb * 64; src = a.w_in + (size_t)k0 * NIN + (nb < 128 ? nb * 32 : 5200 + 1024 * (FP8_HG - 1) + (nb - 128) * 32); }
    };
    const int ITOT = I_IN + I_OUT + I_8;
    float cur[32], nxv[32];
    const float* csrc = nullptr; int cN = 0, cnv = 0, ckind = 0, cdrow = 0, ck0 = 0;
    if (gw < ITOT) { decode(gw, csrc, cN, cnv, ckind, cdrow, ck0);
#pragma unroll
        for (int i = 0; i < 32; ++i) cur[i] = ((lane & 31) < cnv) ? csrc[(size_t)(2 * i + (lane >> 5)) * cN + (lane & 31)] : 0.f; }
    for (int it = gw; it < ITOT; it += NGW) {
        const float* nsrc = nullptr; int nN = 0, nnv = 0, nkind = 0, ndrow = 0, nk0 = 0;
        if (it + NGW < ITOT) { decode(it + NGW, nsrc, nN, nnv, nkind, ndrow, nk0);
#pragma unroll
            for (int i = 0; i < 32; ++i) nxv[i] = ((lane & 31) < nnv) ? nsrc[(size_t)(2 * i + (lane >> 5)) * nN + (lane & 31)] : 0.f; }
#pragma unroll
        for (int i = 0; i < 32; ++i) scr[(2 * i + (lane >> 5)) * 33 + (lane & 31)] = cur[i];
        asm volatile("s_waitcnt lgkmcnt(0)" ::: "memory");
        if (ckind < 2) { bf16* WT = ckind ? WOUT : WIN; const int c = lane & 7;
#pragma unroll
            for (int j = 0; j < 4; ++j) { const int n = (lane >> 3) + 8 * j; const LAS float* sq = scr + (8 * c) * 33 + n;
                v4u o; o.x = pk2(sq[0 * 33], sq[1 * 33]); o.y = pk2(sq[2 * 33], sq[3 * 33]); o.z = pk2(sq[4 * 33], sq[5 * 33]); o.w = pk2(sq[6 * 33], sq[7 * 33]);
                *(v4u*)(WT + (size_t)(cdrow + n) * DM + ck0 + 8 * c) = o; }
        } else { const int n = lane >> 1, hf = lane & 1; const LAS float* sp = scr + (32 * hf) * 33 + n; v4u w0, w1; int t_;
#define W8PK(D, I) t_ = __builtin_amdgcn_cvt_pk_fp8_f32(sp[(I) * 33] * 32.f, sp[((I) + 1) * 33] * 32.f, 0, false); t_ = __builtin_amdgcn_cvt_pk_fp8_f32(sp[((I) + 2) * 33] * 32.f, sp[((I) + 3) * 33] * 32.f, t_, true); D = (unsigned)t_
            W8PK(w0.x, 0); W8PK(w0.y, 4); W8PK(w0.z, 8); W8PK(w0.w, 12); W8PK(w1.x, 16); W8PK(w1.y, 20); W8PK(w1.z, 24); W8PK(w1.w, 28);
#undef W8PK
            unsigned char* dst = W8 + (size_t)(cdrow + n) * DM + ck0 + 32 * hf;
            *(v4u*)dst = w0; *(v4u*)(dst + 16) = w1; }
        asm volatile("s_waitcnt lgkmcnt(0)" ::: "memory");
#pragma unroll
        for (int i = 0; i < 32; ++i) cur[i] = nxv[i];
        csrc = nsrc; cN = nN; cnv = nnv; ckind = nkind; cdrow = ndrow; ck0 = nk0;
    }
    float* mod = (float*)(a.ws + WS_CTL);
    if (do_gemv) for (int kb = blockIdx.x; kb < DM / 8; kb += gridDim.x) {
        f32x4 acc[3];
#pragma unroll
        for (int j = 0; j < 3; ++j) acc[j] = (f32x4){0.f, 0.f, 0.f, 0.f};
#pragma unroll
        for (int r = 0; r < 8; ++r) { const float s = siluf_(a.c[kb * 8 + r]); const f32x4* wr = (const f32x4*)(a.ada_w + (size_t)(kb * 8 + r) * (3 * DM));
#pragma unroll
            for (int j = 0; j < 3; ++j) acc[j] += s * wr[tid + 512 * j]; }
#pragma unroll
        for (int j = 0; j < 3; ++j) { const int c0 = 4 * (tid + 512 * j);
            if (kb == 0) acc[j] += *(const f32x4*)(a.ada_b + c0);
            atomicAdd(mod + c0 + 0, acc[j][0]); atomicAdd(mod + c0 + 1, acc[j][1]); atomicAdd(mod + c0 + 2, acc[j][2]); atomicAdd(mod + c0 + 3, acc[j][3]); }
    }
}

__device__ __forceinline__ void phase1(const Args& a, int wave, int lane) {
    const float* mod = (const float*)(a.ws + WS_CTL); bf16* H = (bf16*)(a.ws + WS_H);
    const int gw = blockIdx.x * NWAVES + wave, NGW = gridDim.x * NWAVES;
    if (gw >= SEQ) return;
    f32x4 fa[8], fb[8];
#pragma unroll
    for (int j = 0; j < 8; ++j) { const int c0 = 4 * lane + 256 * j;
        const f32x4 g = *(const f32x4*)(a.norm_g + c0), sh = *(const f32x4*)(mod + c0), sc = *(const f32x4*)(mod + DM + c0);
        fa[j] = g * (sc + 1.0f); fb[j] = sh; }
    f32x4 v[8], nx[8];
    { const f32x4* xr = (const f32x4*)(a.x + (size_t)gw * DM) + lane;
#pragma unroll
      for (int j = 0; j < 8; ++j) v[j] = xr[64 * j]; }
    for (int m = gw; m < SEQ; m += NGW) {
        if (m + NGW < SEQ) { const f32x4* xn = (const f32x4*)(a.x + (size_t)(m + NGW) * DM) + lane;
#pragma unroll
            for (int j = 0; j < 8; ++j) nx[j] = xn[64 * j]; }
        float s = 0.f;
#pragma unroll
        for (int j = 0; j < 8; ++j) s += (v[j][0] * v[j][0] + v[j][1] * v[j][1]) + (v[j][2] * v[j][2] + v[j][3] * v[j][3]);
        const float rstd = rsqrtf(wave_sum(s) * (1.f / DM) + EPS);
        v2u* o8 = (v2u*)(H + (size_t)m * DM) + lane; unsigned* h8 = (unsigned*)(a.ws + WS_H8 + (size_t)m * DM) + lane;
#pragma unroll
        for (int j = 0; j < 8; ++j) {
            const f32x4 y = (v[j] * rstd) * fa[j] + fb[j];
            v2u w; w.x = pk2(y[0], y[1]); w.y = pk2(y[2], y[3]); o8[64 * j] = w;
            int t_ = __builtin_amdgcn_cvt_pk_fp8_f32(y[0], y[1], 0, false); t_ = __builtin_amdgcn_cvt_pk_fp8_f32(y[2], y[3], t_, true); h8[64 * j] = (unsigned)t_; }
#pragma unroll
        for (int j = 0; j < 8; ++j) v[j] = nx[j];
    }
}

__device__ __forceinline__ void rope_cs(float posf, const float* invf, int d0, float (&cs)[8], float (&sn)[8]) {
#pragma unroll
    for (int e = 0; e < 8; ++e) { const float ang = posf * invf[d0 + e];
        double fr = (double)ang * 0.15915494309189535; fr = fr - __builtin_rint(fr); const float f = (float)fr;
        cs[e] = __builtin_amdgcn_cosf(f); sn[e] = __builtin_amdgcn_sinf(f); }
}
__device__ __forceinline__ void phase3_post(const Args& a, int wave, int lane) {
    bf16* Q = (bf16*)(a.ws + WS_PROJ + PB_Q * PROJ_STRIDE); bf16* K = (bf16*)(a.ws + WS_PROJ + PB_K * PROJ_STRIDE); bf16* QI = (bf16*)(a.ws + WS_PROJ + PB_QI * PROJ_STRIDE);
    const float* TAIL = (const float*)(a.ws + WS_TAIL); bf16* IKB = (bf16*)(a.ws + WS_IKB); bf16* KF = (bf16*)(a.ws + WS_KF); float* STAT = (float*)(a.ws + WS_STAT);
    const int gw = blockIdx.x * NWAVES + wave, NGW = gridDim.x * NWAVES;
    for (int m = gw; m < SEQ; m += NGW) {
        const float posf = (float)a.pos[m];
        {
            const int hd = lane >> 3, j = lane & 7; float cs[8], sn[8]; rope_cs(posf, a.invf_a, 8 * j, cs, sn);
            constexpr float C2 = 0.71419166f;
#pragma unroll
            for (int which = 0; which < 2; ++which) {
                bf16* base = (which ? K : Q) + (size_t)m * 1024 + hd * 128 + 8 * j; const float* g = which ? a.k_norm_g : a.q_norm_g;
                float xa[8], xb[8]; unpack8(*(const v4u*)base, xa); unpack8(*(const v4u*)(base + 64), xb);
                float ss = 0.f;
#pragma unroll
                for (int e = 0; e < 8; ++e) ss += xa[e] * xa[e] + xb[e] * xb[e];
                ss += __shfl_xor(ss, 1); ss += __shfl_xor(ss, 2); ss += __shfl_xor(ss, 4);
                const float rstd = rsqrtf(ss * (1.f / 128.f) + EPS) * C2;
                float oa[8], ob[8];
#pragma unroll
                for (int e = 0; e < 8; ++e) { const float ya = xa[e] * rstd * g[8 * j + e], yb = xb[e] * rstd * g[64 + 8 * j + e];
                    oa[e] = ya * cs[e] - yb * sn[e]; ob[e] = yb * cs[e] + ya * sn[e]; }
                if (which == 0) { *(v4u*)base = pack8(oa); *(v4u*)(base + 64) = pack8(ob); }
                else {
                    const int kk = m & 31, r = (kk & 0x13) | ((kk & 4) << 1) | ((kk & 8) >> 1);
                    unsigned char* tb = (unsigned char*)KF + (size_t)(hd * 512 + (m >> 5)) * 4096 + (size_t)((j >> 1) & 1) * 1024 + ((j >> 2) * 32 + r) * 16 + 8 * (j & 1);
                    v2u wa, wb; int t_;
                    t_ = __builtin_amdgcn_cvt_pk_fp8_f32(oa[0], oa[1], 0, false); t_ = __builtin_amdgcn_cvt_pk_fp8_f32(oa[2], oa[3], t_, true); wa.x = (unsigned)t_;
                    t_ = __builtin_amdgcn_cvt_pk_fp8_f32(oa[4], oa[5], 0, false); t_ = __builtin_amdgcn_cvt_pk_fp8_f32(oa[6], oa[7], t_, true); wa.y = (unsigned)t_;
                    t_ = __builtin_amdgcn_cvt_pk_fp8_f32(ob[0], ob[1], 0, false); t_ = __builtin_amdgcn_cvt_pk_fp8_f32(ob[2], ob[3], t_, true); wb.x = (unsigned)t_;
                    t_ = __builtin_amdgcn_cvt_pk_fp8_f32(ob[4], ob[5], 0, false); t_ = __builtin_amdgcn_cvt_pk_fp8_f32(ob[6], ob[7], t_, true); wb.y = (unsigned)t_;
                    *(v2u*)tb = wa; *(v2u*)(tb + 2048) = wb;
                }
            }
        }
        {
            const int hd = lane >> 2, j = lane & 3; float cs[8], sn[8]; rope_cs(posf, a.invf_i, 8 * j, cs, sn);
            bf16* base = QI + (size_t)m * 1024 + hd * 64 + 8 * j;
            float xa[8], xb[8]; unpack8(*(const v4u*)base, xa); unpack8(*(const v4u*)(base + 32), xb);
            float oa[8], ob[8];
#pragma unroll
            for (int e = 0; e < 8; ++e) { oa[e] = xa[e] * cs[e] - xb[e] * sn[e]; ob[e] = xb[e] * cs[e] + xa[e] * sn[e]; }
            *(v4u*)base = pack8(oa); *(v4u*)(base + 32) = pack8(ob);
            {
                float sq = 0.f;
#pragma unroll
                for (int e = 0; e < 8; ++e) sq += xa[e] * xa[e] + xb[e] * xb[e];
                sq += __shfl_xor(sq, 1); sq += __shfl_xor(sq, 2);
                const float wh = TAIL[(size_t)m * 128 + 64 + hd] * 0.25f, sg = 0.125f * sqrtf(sq);
                const float mu = 0.25f * wave_sum(wh * sg * 0.39894228f), var = 0.25f * wave_sum(wh * wh * sg * sg * 0.34084f);
                if (lane == 0) { STAT[2 * m] = mu; STAT[2 * m + 1] = 24.0f * rsqrtf(fmaxf(var, 1e-20f)); }
            }
            const float* tr = TAIL + (size_t)m * 128;
            const f32x4 a0 = *(const f32x4*)(tr + 8 * j), a1 = *(const f32x4*)(tr + 8 * j + 4), b0 = *(const f32x4*)(tr + 32 + 8 * j), b1 = *(const f32x4*)(tr + 32 + 8 * j + 4);
            float ka[8] = {a0[0], a0[1], a0[2], a0[3], a1[0], a1[1], a1[2], a1[3]}, kb[8] = {b0[0], b0[1], b0[2], b0[3], b1[0], b1[1], b1[2], b1[3]};
            float ss = 0.f;
#pragma unroll
            for (int e = 0; e < 8; ++e) ss += ka[e] * ka[e] + kb[e] * kb[e];
            ss += __shfl_xor(ss, 1); ss += __shfl_xor(ss, 2);
            const float rstd = rsqrtf(ss * (1.f / 64.f) + EPS);
#pragma unroll
            for (int e = 0; e < 8; ++e) { const float ya = ka[e] * rstd * a.ik_norm_g[8 * j + e], yb = kb[e] * rstd * a.ik_norm_g[32 + 8 * j + e];
                oa[e] = ya * cs[e] - yb * sn[e]; ob[e] = yb * cs[e] + ya * sn[e]; }
            if (lane < 4) {
                const size_t g = (size_t)(m >> 5), c = (size_t)(m & 31); const int s0 = j >> 1, h = j & 1;
                *(v4u*)(IKB + (((g * 4 + s0) * 64) + h * 32 + c) * 8) = pack8(oa);
                *(v4u*)(IKB + (((g * 4 + 2 + s0) * 64) + h * 32 + c) * 8) = pack8(ob);
            }
        }
    }
}

constexpr int HG_TOK = 512, HG_NG = SEQ / HG_TOK;
constexpr int HL_B = 0, HL_K1 = 32768, HL_QD = 49152, HL_KD = 66560, HL_QB = 83968, HL_KLT = 101376, HL_IT = 119808, HL_A = 138240, HL_DEC = 147456, HL_END = 147968;
static_assert(HL_END + 512 <= LDS_BYTES, "hgrn LDS");
typedef float f32x4h __attribute__((ext_vector_type(4)));
template <bool OUTPUT>
__device__ __forceinline__ void hgrn_unit(const Args& a, LAS unsigned char* lds, int hd, int g, int tid, int wave, int lane) {
    const bf16* RQ = (const bf16*)(a.ws + WS_PROJ + PB_RQ * PROJ_STRIDE); const bf16* RF = (const bf16*)(a.ws + WS_PROJ + PB_RF * PROJ_STRIDE);
    const bf16* RI = (const bf16*)(a.ws + WS_PROJ + PB_RI * PROJ_STRIDE); const bf16* RG = (const bf16*)(a.ws + WS_PROJ + PB_RG * PROJ_STRIDE);
    float* GS = (float*)(a.ws + WS_GS); float* GD = (float*)(a.ws + WS_GD); bf16* MIX = (bf16*)(a.ws + WS_H);
    LAS float* Bf = (LAS float*)(lds + HL_B); LAS unsigned short* K1 = (LAS unsigned short*)(lds + HL_K1); LAS float* decs = (LAS float*)(lds + HL_DEC);
    LAS float* tot = (LAS float*)(lds + HL_A);
    const int fr = lane & 15, fg = lane >> 4;
    const int c8 = tid & 15;
    LAS float* lbv = (LAS float*)(lds + HL_END);
    if (tid < 128) { const int col = hd * 128 + tid; lbv[tid] = __builtin_amdgcn_rcpf(1.0f + __expf(a.lb_logits[1024 + col] - a.lb_logits[col])); }
    __syncthreads();
    f32x4h Sacc[8];
    const size_t sbase = ((size_t)(hd * HG_NG + g) * 128) * 128;
    const int ecol = 16 * wave + fr;
#pragma unroll
    for (int dt = 0; dt < 8; ++dt)
#pragma unroll
        for (int rg = 0; rg < 4; ++rg) Sacc[dt][rg] = OUTPUT ? GS[sbase + (size_t)(16 * dt + 4 * fg + rg) * 128 + ecol] : 0.f;
    float gdl = 0.f;
    const int tok0 = g * HG_TOK;
    v4u pfF[2], pfI[2], pfQ[2];
#pragma unroll
    for (int rep2 = 0; rep2 < 2; ++rep2) { const size_t off = (size_t)(tok0 + (tid >> 4) + 32 * rep2) * 1024 + hd * 128 + 8 * c8;
        pfF[rep2] = *(const v4u*)(RF + off); pfI[rep2] = *(const v4u*)(RI + off); if (OUTPUT) pfQ[rep2] = *(const v4u*)(RQ + off); }
    for (int ch = 0; ch < HG_TOK / 64; ++ch) {
        const int t0 = tok0 + 64 * ch;
        const int tnx = tok0 + 64 * (ch + 1 < HG_TOK / 64 ? ch + 1 : ch);
#pragma unroll
        for (int rep2 = 0; rep2 < 2; ++rep2) { const int s = (tid >> 4) + 32 * rep2;
            float f[8]; unpack8(pfF[rep2], f); float kk[8];
            const f32x4 l0 = *(const LAS f32x4*)(lbv + 8 * c8), l1 = *(const LAS f32x4*)(lbv + 8 * c8 + 4);
            const float lb8[8] = {l0[0], l0[1], l0[2], l0[3], l1[0], l1[1], l1[2], l1[3]};
#pragma unroll
            for (int e = 0; e < 8; ++e) { const float fv = lb8[e] + (1.0f - lb8[e]) * sigmoidf_(f[e]); kk[e] = 1.0f - fv; f[e] = __logf(fv); }
            *(LAS f32x4*)(Bf + s * 128 + 8 * c8) = (f32x4){f[0], f[1], f[2], f[3]}; *(LAS f32x4*)(Bf + s * 128 + 8 * c8 + 4) = (f32x4){f[4], f[5], f[6], f[7]};
            *(LAS v4u*)(K1 + s * 128 + 8 * c8) = pack8(kk);
            const v4u iv = pfI[rep2];
            LAS unsigned short* itp = (LAS unsigned short*)(lds + HL_IT) + (8 * c8) * 72 + s;
            itp[0 * 72] = (unsigned short)(iv.x & 0xffffu); itp[1 * 72] = (unsigned short)(iv.x >> 16); itp[2 * 72] = (unsigned short)(iv.y & 0xffffu); itp[3 * 72] = (unsigned short)(iv.y >> 16);
            itp[4 * 72] = (unsigned short)(iv.z & 0xffffu); itp[5 * 72] = (unsigned short)(iv.z >> 16); itp[6 * 72] = (unsigned short)(iv.w & 0xffffu); itp[7 * 72] = (unsigned short)(iv.w >> 16); }
#pragma unroll
        for (int rep2 = 0; rep2 < 2; ++rep2) { const size_t offn = (size_t)(tnx + (tid >> 4) + 32 * rep2) * 1024 + hd * 128 + 8 * c8;
            pfF[rep2] = *(const v4u*)(RF + offn); pfI[rep2] = *(const v4u*)(RI + offn); }
        __syncthreads();
        { const int d = tid & 127, qq = tid >> 7; float cv[16];
#pragma unroll
            for (int k = 0; k < 16; ++k) cv[k] = Bf[(16 * qq + k) * 128 + d];
#pragma unroll
            for (int k = 1; k < 16; ++k) cv[k] += cv[k - 1];
            tot[qq * 128 + d] = cv[15];
            __syncthreads();
            float offv = 0.f;
#pragma unroll
            for (int q2 = 0; q2 < 3; ++q2) offv += (q2 < qq) ? tot[q2 * 128 + d] : 0.f;
#pragma unroll
            for (int k = 0; k < 16; ++k) Bf[(16 * qq + k) * 128 + d] = cv[k] + offv;
            if (qq == 3) { const float bl = cv[15] + offv; decs[d] = __expf(bl); if (!OUTPUT) gdl += bl; }
        }
        __syncthreads();
        if (OUTPUT) {
#pragma unroll
            for (int rep2 = 0; rep2 < 2; ++rep2) { const int s = (tid >> 4) + 32 * rep2;
                float q[8]; unpack8(pfQ[rep2], q); float kk[8]; unpack8(*(const LAS v4u*)(K1 + s * 128 + 8 * c8), kk);
                const f32x4 b0 = *(const LAS f32x4*)(Bf + s * 128 + 8 * c8), b1 = *(const LAS f32x4*)(Bf + s * 128 + 8 * c8 + 4);
                const f32x4 m0 = *(const LAS f32x4*)(Bf + 31 * 128 + 8 * c8), m1 = *(const LAS f32x4*)(Bf + 31 * 128 + 8 * c8 + 4);
                const float bv[8] = {b0[0], b0[1], b0[2], b0[3], b1[0], b1[1], b1[2], b1[3]}, mv[8] = {m0[0], m0[1], m0[2], m0[3], m1[0], m1[1], m1[2], m1[3]};
                float qd[8], kd[8], qb[8];
#pragma unroll
                for (int e = 0; e < 8; ++e) { const float qs = siluf_(q[e]); qb[e] = qs * __expf(bv[e]); qd[e] = qs * __expf(bv[e] - mv[e]); kd[e] = kk[e] * __expf(mv[e] - bv[e]); }
                *(LAS v4u*)(lds + HL_QD + (s * 136 + 8 * c8) * 2) = pack8(qd); *(LAS v4u*)(lds + HL_KD + (s * 136 + 8 * c8) * 2) = pack8(kd); *(LAS v4u*)(lds + HL_QB + (s * 136 + 8 * c8) * 2) = pack8(qb); }
#pragma unroll
            for (int rep2 = 0; rep2 < 2; ++rep2) pfQ[rep2] = *(const v4u*)(RQ + (size_t)(tnx + (tid >> 4) + 32 * rep2) * 1024 + hd * 128 + 8 * c8);
        }
#pragma unroll
        for (int rep2 = 0; rep2 < 2; ++rep2) { const int it = tid + 512 * rep2; const int d = it & 127, s0 = 8 * (it >> 7); const float bl = Bf[63 * 128 + d]; float kl[8];
#pragma unroll
            for (int jx = 0; jx < 8; ++jx) { const float kv = bflo((unsigned)K1[(s0 + jx) * 128 + d]); kl[jx] = kv * __expf(bl - Bf[(s0 + jx) * 128 + d]); }
            *(LAS v4u*)(lds + HL_KLT + (d * 72 + s0) * 2) = pack8(kl); }
        __syncthreads();
        f32x4h oacc[4];
        unsigned gpre[8];
        if (OUTPUT) {
#pragma unroll
            for (int i2 = 0; i2 < 8; ++i2) gpre[i2] = *(const unsigned*)(RG + (size_t)(t0 + 8 * wave + i2) * 1024 + hd * 128 + 2 * lane);
#pragma unroll
            for (int k2 = 0; k2 < 2; ++k2) { const int tl = 2 * wave + k2, st = tl >> 2, ct = tl & 3;
                f32x4h acc = {0.f, 0.f, 0.f, 0.f};
                if (st <= ct) {
#pragma unroll
                    for (int ks = 0; ks < 4; ++ks) { const bf16x8 A = *(const LAS bf16x8*)(lds + HL_KD + ((16 * st + fr) * 136 + 32 * ks + 8 * fg) * 2);
                        const bf16x8 B = *(const LAS bf16x8*)(lds + HL_QD + ((16 * ct + fr) * 136 + 32 * ks + 8 * fg) * 2);
                        acc = __builtin_amdgcn_mfma_f32_16x16x32_bf16(A, B, acc, 0, 0, 0); } }
                const int cidx = 16 * ct + fr, sidx = 16 * st + 4 * fg;
                v2u w; w.x = pk2(sidx + 0 <= cidx ? acc[0] : 0.f, sidx + 1 <= cidx ? acc[1] : 0.f); w.y = pk2(sidx + 2 <= cidx ? acc[2] : 0.f, sidx + 3 <= cidx ? acc[3] : 0.f);
                *(LAS v2u*)(lds + HL_A + (cidx * 72 + sidx) * 2) = w; }
            __syncthreads();
#pragma unroll
            for (int ct = 0; ct < 4; ++ct) { oacc[ct] = (f32x4h){0.f, 0.f, 0.f, 0.f};
#pragma unroll
                for (int ks = 0; ks < 2; ++ks) if (ks == 0 || ct >= 2) { const bf16x8 A = *(const LAS bf16x8*)(lds + HL_A + ((16 * ct + fr) * 72 + 32 * ks + 8 * fg) * 2);
                    const bf16x8 B = *(const LAS bf16x8*)(lds + HL_IT + ((16 * wave + fr) * 72 + 32 * ks + 8 * fg) * 2);
                    oacc[ct] = __builtin_amdgcn_mfma_f32_16x16x32_bf16(A, B, oacc[ct], 0, 0, 0); } }
#pragma unroll
            for (int k4 = 0; k4 < 4; ++k4) { v4u sw; sw.x = pk2(Sacc[2 * k4][0], Sacc[2 * k4][1]); sw.y = pk2(Sacc[2 * k4][2], Sacc[2 * k4][3]); sw.z = pk2(Sacc[2 * k4 + 1][0], Sacc[2 * k4 + 1][1]); sw.w = pk2(Sacc[2 * k4 + 1][2], Sacc[2 * k4 + 1][3]);
                const bf16x8 Sb = __builtin_bit_cast(bf16x8, sw);
#pragma unroll
                for (int ct = 0; ct < 4; ++ct) { const v2u lo = *(const LAS v2u*)(lds + HL_QB + ((16 * ct + fr) * 136 + 32 * k4 + 4 * fg) * 2), hi2 = *(const LAS v2u*)(lds + HL_QB + ((16 * ct + fr) * 136 + 32 * k4 + 16 + 4 * fg) * 2);
                    v4u aw; aw.x = lo.x; aw.y = lo.y; aw.z = hi2.x; aw.w = hi2.y;
                    oacc[ct] = __builtin_amdgcn_mfma_f32_16x16x32_bf16(__builtin_bit_cast(bf16x8, aw), Sb, oacc[ct], 0, 0, 0); } }
        }
#pragma unroll
        for (int dt = 0; dt < 8; ++dt) { const f32x4 dc = *(const LAS f32x4*)(decs + 16 * dt + 4 * fg);
            Sacc[dt][0] *= dc[0]; Sacc[dt][1] *= dc[1]; Sacc[dt][2] *= dc[2]; Sacc[dt][3] *= dc[3];
#pragma unroll
            for (int ks = 0; ks < 2; ++ks) { const bf16x8 A = *(const LAS bf16x8*)(lds + HL_KLT + ((16 * dt + fr) * 72 + 32 * ks + 8 * fg) * 2);
                const bf16x8 B = *(const LAS bf16x8*)(lds + HL_IT + ((16 * wave + fr) * 72 + 32 * ks + 8 * fg) * 2);
                Sacc[dt] = __builtin_amdgcn_mfma_f32_16x16x32_bf16(A, B, Sacc[dt], 0, 0, 0); } }
        if (OUTPUT) {
#pragma unroll
            for (int ct = 0; ct < 4; ++ct)
#pragma unroll
                for (int rg = 0; rg < 4; ++rg) Bf[(16 * ct + 4 * fg + rg) * 128 + ecol] = oacc[ct][rg];
            __syncthreads();
#pragma unroll
            for (int i2 = 0; i2 < 8; ++i2) { const int c = 8 * wave + i2; const int m = t0 + c;
                const float o0 = Bf[c * 128 + 2 * lane], o1 = Bf[c * 128 + 2 * lane + 1];
                const float rstd = rsqrtf(wave_sum(o0 * o0 + o1 * o1) * (1.f / 128.f) + EPS);
                const unsigned gw2 = gpre[i2];
                const float y0 = o0 * rstd * a.hgrn_norm_g[2 * lane] * siluf_(bflo(gw2)), y1 = o1 * rstd * a.hgrn_norm_g[2 * lane + 1] * siluf_(bfhi(gw2));
                *(unsigned*)(MIX + (size_t)m * DM + 1024 + hd * 128 + 2 * lane) = pk2(y0, y1); }
        }
        __syncthreads();
    }
    if (!OUTPUT) {
#pragma unroll
        for (int dt = 0; dt < 8; ++dt)
#pragma unroll
            for (int rg = 0; rg < 4; ++rg) GS[sbase + (size_t)(16 * dt + 4 * fg + rg) * 128 + ecol] = Sacc[dt][rg];
        if (tid >= 384) GD[(size_t)(hd * HG_NG + g) * 128 + (tid & 127)] = __expf(gdl);
    }
}
__device__ __forceinline__ void hgrn_scan(const Args& a, int tid) {
    float* GS = (float*)(a.ws + WS_GS); const float* GD = (const float*)(a.ws + WS_GD);
    for (int id = blockIdx.x * NTHR + tid; id < BH * 128 * 128; id += gridDim.x * NTHR) {
        const int hd = id >> 14, d = (id >> 7) & 127, e = id & 127;
        float gs[HG_NG], gd[HG_NG];
#pragma unroll
        for (int g = 0; g < HG_NG; ++g) { gs[g] = GS[((size_t)(hd * HG_NG + g) * 128 + d) * 128 + e]; gd[g] = GD[(size_t)(hd * HG_NG + g) * 128 + d]; }
        float carry = 0.f;
#pragma unroll
        for (int g = 0; g < HG_NG; ++g) { GS[((size_t)(hd * HG_NG + g) * 128 + d) * 128 + e] = carry; carry = carry * gd[g] + gs[g]; }
    }
}

constexpr int IX_BINS = 0, IX_STG = 131072, IX_HIST = IX_STG + 16384, IX_CTL = IX_HIST + 8192, IX_CAP = 128;
static_assert(IX_CTL + 256 <= LDS_BYTES, "indexer LDS");
__device__ __forceinline__ void indexer_phase(const Args& a, LAS unsigned char* lds, int tid, int wave, int lane) {
    const bf16* QI = (const bf16*)(a.ws + WS_PROJ + PB_QI * PROJ_STRIDE); const bf16* IKB = (const bf16*)(a.ws + WS_IKB); const float* TAIL = (const float*)(a.ws + WS_TAIL);
    const float* STAT = (const float*)(a.ws + WS_STAT); unsigned* MASK = (unsigned*)(a.ws + WS_MASK);
    LAS unsigned char* bins = lds + IX_BINS; LAS unsigned* hist = (LAS unsigned*)(lds + IX_HIST); LAS unsigned short* ckeys = (LAS unsigned short*)(lds + IX_HIST);
    LAS float* cscore = (LAS float*)(lds + IX_HIST + 2048); LAS unsigned char* qst = lds + IX_STG; LAS int* ctl = (LAS int*)(lds + IX_CTL);
    const int G = gridDim.x, NU = SEQ / 8, rounds = (NU + G - 1) / G;
    const int r = lane & 31, h = lane >> 5;
    bf16x8 af[4][4]; float wv[4][16], mu[4], bsc[4]; int loaded = -1;
#define IX_LOADA(M0) do { const int qq_ = (r >> 2) & 1, head_ = (r & 3) + 4 * (r >> 3); \
        _Pragma("unroll") for (int p = 0; p < 4; ++p) { \
            _Pragma("unroll") for (int s = 0; s < 4; ++s) af[p][s] = *(const bf16x8*)(QI + (size_t)((M0) + 2 * p + qq_) * 1024 + head_ * 64 + 16 * s + 8 * h); \
            const float* wr_ = TAIL + (size_t)((M0) + 2 * p + h) * 128 + 64; \
            _Pragma("unroll") for (int t4 = 0; t4 < 4; ++t4) { const f32x4 w4 = *(const f32x4*)(wr_ + 4 * t4); wv[p][4 * t4] = w4[0]; wv[p][4 * t4 + 1] = w4[1]; wv[p][4 * t4 + 2] = w4[2]; wv[p][4 * t4 + 3] = w4[3]; } \
            mu[p] = STAT[2 * ((M0) + 2 * p + h)]; bsc[p] = STAT[2 * ((M0) + 2 * p + h) + 1]; } } while (0)
    for (int j = 0; j < rounds; ++j) {
        const int bx = __builtin_amdgcn_readfirstlane((int)blockIdx.x);
        const int u = (j & 1) ? (j * G + (G - 1 - bx)) : (j * G + bx);
        if (u >= NU) continue;
        const int m0 = 8 * u, L = 64 * ((m0 >> 6) + 1);
        if (L <= 256) {
            for (int w = tid; w < 4096; w += NTHR) { const int ww = w & 511; MASK[(size_t)(m0 + (w >> 9)) * 512 + ww] = (ww < (L >> 5)) ? 0xffffffffu : 0u; }
            continue;
        }
        const v4u qs0 = ((const v4u*)(QI + (size_t)(m0 + wave) * 1024))[lane], qs1 = ((const v4u*)(QI + (size_t)(m0 + wave) * 1024))[64 + lane];
        if (loaded != u) { IX_LOADA(m0); loaded = u; }
        for (int w = tid; w < 2048; w += NTHR) hist[w] = 0u;
        if (tid < 24) ctl[tid] = 0;
        __syncthreads();
        for (int rp = 0; rp < IXP_SCORE; ++rp) {
            if (rp > 0) { __syncthreads(); for (int w = tid; w < 2048; w += NTHR) hist[w] = 0u; __syncthreads(); }
            if (rp == 0) {
#pragma unroll
                for (int p = 0; p < 4; ++p) { mu[p] = 128.f - mu[p] * bsc[p]; bsc[p] *= 0.03125f; } }
            if (rp == 0) { *(LAS v4u*)(qst + wave * 2048 + lane * 16) = qs0; *(LAS v4u*)(qst + wave * 2048 + 1024 + lane * 16) = qs1; }
            const int ng = L >> 5;
            const bf16x8* bp = (const bf16x8*)IKB + lane;
#define IX_LOADB(B, GG) do { const int gk = ((GG) < ng) ? (GG) : ng - 1; _Pragma("unroll") for (int s = 0; s < 4; ++s) B[s] = bp[(size_t)gk * 256 + s * 64]; } while (0)
#define IX_VALU_(ACC, P) do { float s0 = 0.f, s1 = 0.f, s2 = 0.f, s3 = 0.f; \
                    _Pragma("unroll") for (int t = 0; t < 4; ++t) { s0 = fmaf(relu1(ACC[4 * t]), wv[P][4 * t], s0); s1 = fmaf(relu1(ACC[4 * t + 1]), wv[P][4 * t + 1], s1); \
                        s2 = fmaf(relu1(ACC[4 * t + 2]), wv[P][4 * t + 2], s2); s3 = fmaf(relu1(ACC[4 * t + 3]), wv[P][4 * t + 3], s3); } \
                    const float sv = (s0 + s1) + (s2 + s3); \
                    int b; asm("v_cvt_flr_i32_f32_e32 %0, %1" : "=v"(b) : "v"(fmaf(sv, bsc[P], mu[P]))); b = b < 0 ? 0 : (b > 255 ? 255 : b); \
                    bins[boff + 2 * (P) + h] = (unsigned char)b; \
                    __hip_atomic_fetch_add(&hist[(2 * (P) + h) * 256 + b], 1u, __ATOMIC_RELAXED, __HIP_MEMORY_SCOPE_WORKGROUP); } while (0)
#define IX_GROUP(B, GG) do { const int key = 32 * (GG) + r; const int boff = 8 * key; \
                _Pragma("unroll") for (int pj = 0; pj < 2; ++pj) { f32x16 accA, accB; \
                    _Pragma("unroll") for (int t = 0; t < 16; ++t) { accA[t] = 0.f; accB[t] = 0.f; } \
                    __builtin_amdgcn_sched_barrier(0); \
                    _Pragma("unroll") for (int s = 0; s < 4; ++s) { accA = __builtin_amdgcn_mfma_f32_32x32x16_bf16(af[2 * pj][s], B[s], accA, 0, 0, 0); \
                        accB = __builtin_amdgcn_mfma_f32_32x32x16_bf16(af[2 * pj + 1][s], B[s], accB, 0, 0, 0); } \
                    asm volatile("" : "+v"(accA), "+v"(accB)); \
                    __builtin_amdgcn_sched_barrier(0); \
                    IX_VALU_(accA, 2 * pj); IX_VALU_(accB, 2 * pj + 1); } } while (0)
            bf16x8 b0[4], b1[4];
            int g = wave;
            if (g < ng) {
                IX_LOADB(b0, g);
                for (;;) {
                    IX_LOADB(b1, g + 8);
                    IX_GROUP(b0, g);
                    g += 8; if (g >= ng) break;
                    IX_LOADB(b0, g + 8);
                    IX_GROUP(b1, g);
                    g += 8; if (g >= ng) break;
                }
            }
#undef IX_LOADB
#undef IX_GROUP
#undef IX_VALU_
        }
        __syncthreads();
        int m0t = __builtin_amdgcn_readfirstlane(m0); asm volatile("" : "+s"(m0t));
        {
            const v4u hv = *(const LAS v4u*)(hist + wave * 256 + 4 * lane);
            unsigned v = hv.x + hv.y + hv.z + hv.w;
#pragma unroll
            for (int off = 1; off < 64; off <<= 1) { const unsigned t = __shfl_down(v, off); if (lane + off < 64) v += t; }
            const unsigned long long bal = __ballot(v >= 256u);
            const int ls = 63 - __builtin_clzll(bal);
            unsigned above = __shfl_down(v, 1); if (lane == 63) above = 0u;
            if (lane == ls) { unsigned run = above; int bs, need;
                if (run + hv.w >= 256u) { bs = 3; need = 256 - (int)run; }
                else { run += hv.w; if (run + hv.z >= 256u) { bs = 2; need = 256 - (int)run; }
                    else { run += hv.z; if (run + hv.y >= 256u) { bs = 1; need = 256 - (int)run; } else { run += hv.y; bs = 0; need = 256 - (int)run; } } }
                ctl[wave] = 4 * lane + bs; ctl[8 + wave] = need; }
        }
        __syncthreads();
        for (int rp = 0; rp < IXP_TAIL; ++rp) {
            if (rp > 0) { __syncthreads(); if (tid < 8) ctl[16 + tid] = 0; __syncthreads(); }
            {
                int bsv[8];
#pragma unroll
                for (int q = 0; q < 8; ++q) bsv[q] = __builtin_amdgcn_readfirstlane(ctl[q]);
                const int ng64 = L >> 6;
                unsigned long long* mbase = (unsigned long long*)(MASK + (size_t)(m0t + (lane & 7)) * 512);
                for (int kg = wave; kg < ng64; kg += NWAVES) { const int key = 64 * kg + lane;
                    const v2u b8 = *(const LAS v2u*)(bins + 8 * key);
                    unsigned long long mine = 0ull; unsigned eq = 0u;
#pragma unroll
                    for (int q = 0; q < 8; ++q) { const int bq = (int)(((q < 4 ? b8.x : b8.y) >> (8 * (q & 3))) & 255u);
                        const unsigned long long m64 = __ballot(bq > bsv[q]);
                        mine = (lane == q) ? m64 : mine; eq |= (bq == bsv[q]) ? (1u << q) : 0u; }
                    if (lane < 8) mbase[kg] = mine;
                    while (eq) { const int q = __builtin_ctz(eq); eq &= eq - 1u;
                        const int p = __hip_atomic_fetch_add(&ctl[16 + q], 1, __ATOMIC_RELAXED, __HIP_MEMORY_SCOPE_WORKGROUP); if (p < IX_CAP) ckeys[q * IX_CAP + p] = (unsigned short)key; } }
                for (int w = tid; w < 8 * 256; w += NTHR) { const int q = w >> 8, kgz = w & 255; if (kgz >= ng64) ((unsigned long long*)(MASK + (size_t)(m0t + q) * 512))[kgz] = 0ull; }
            }
            asm volatile("s_waitcnt vmcnt(0) lgkmcnt(0)" ::: "memory");
            __syncthreads();
            const int q = wave;
            int n = ctl[16 + q]; n = n > IX_CAP ? IX_CAP : n; const int need = ctl[8 + q];
            const float* wrow = TAIL + (size_t)(m0t + q) * 128 + 64;
            const LAS unsigned char* qrow = qst + q * 2048;
            { const int c16 = lane & 15, kq = lane >> 4;
                const bf16x8 qa0 = *(const LAS bf16x8*)(qrow + (c16 * 64 + 8 * kq) * 2), qa1 = *(const LAS bf16x8*)(qrow + (c16 * 64 + 32 + 8 * kq) * 2);
                const f32x4 wq = *(const f32x4*)(wrow + 4 * kq);
                const float w0 = wq[0] * 0.03125f, w1 = wq[1] * 0.03125f, w2 = wq[2] * 0.03125f, w3 = wq[3] * 0.03125f;
                for (int base = 0; base < n; base += 32) {
                    const int i0 = base + c16, i1 = base + 16 + c16;
                    const int key0 = (i0 < n) ? (int)ckeys[q * IX_CAP + i0] : 0, key1 = (i1 < n) ? (int)ckeys[q * IX_CAP + i1] : 0;
                    const bf16* kp0 = IKB + ((size_t)((key0 >> 5) * 4 + (kq >> 1)) * 64 + (kq & 1) * 32 + (key0 & 31)) * 8;
                    const bf16* kp1 = IKB + ((size_t)((key1 >> 5) * 4 + (kq >> 1)) * 64 + (kq & 1) * 32 + (key1 & 31)) * 8;
                    const bf16x8 k00 = *(const bf16x8*)kp0, k01 = *(const bf16x8*)(kp0 + 2 * 64 * 8), k10 = *(const bf16x8*)kp1, k11 = *(const bf16x8*)(kp1 + 2 * 64 * 8);
                    f32x4h x0 = {0.f, 0.f, 0.f, 0.f}, x1 = {0.f, 0.f, 0.f, 0.f};
                    x0 = __builtin_amdgcn_mfma_f32_16x16x32_bf16(qa0, k00, x0, 0, 0, 0); x0 = __builtin_amdgcn_mfma_f32_16x16x32_bf16(qa1, k01, x0, 0, 0, 0);
                    x1 = __builtin_amdgcn_mfma_f32_16x16x32_bf16(qa0, k10, x1, 0, 0, 0); x1 = __builtin_amdgcn_mfma_f32_16x16x32_bf16(qa1, k11, x1, 0, 0, 0);
                    float sv0 = fmaf(fmaxf(x0[3], 0.f), w3, fmaf(fmaxf(x0[2], 0.f), w2, fmaf(fmaxf(x0[1], 0.f), w1, fmaxf(x0[0], 0.f) * w0)));
                    float sv1 = fmaf(fmaxf(x1[3], 0.f), w3, fmaf(fmaxf(x1[2], 0.f), w2, fmaf(fmaxf(x1[1], 0.f), w1, fmaxf(x1[0], 0.f) * w0)));
                    sv0 += __shfl_xor(sv0, 16); sv1 += __shfl_xor(sv1, 16); sv0 += __shfl_xor(sv0, 32); sv1 += __shfl_xor(sv1, 32);
                    if (kq == 0) { if (i0 < n) cscore[q * IX_CAP + i0] = sv0; if (i1 < n) cscore[q * IX_CAP + i1] = sv1; } } }
            asm volatile("s_waitcnt lgkmcnt(0)" ::: "memory");
            if (rp == IXP_TAIL - 1 && j + 1 < rounds) {
                const int un = ((j + 1) & 1) ? ((j + 1) * G + (G - 1 - bx)) : ((j + 1) * G + bx);
                if (un < NU) { IX_LOADA(8 * un); loaded = un; } }
            for (int base = 0; base < n; base += 64) { const int i = base + lane; const bool valid = i < n;
                const int ki = valid ? (int)ckeys[q * IX_CAP + i] : 0; const float si = valid ? cscore[q * IX_CAP + i] : 0.f; int rank = 0;
                for (int jj = 0; jj < n; ++jj) { const int kj = ckeys[q * IX_CAP + jj]; const float sj = cscore[q * IX_CAP + jj]; rank += (sj > si || (sj == si && kj < ki)) ? 1 : 0; }
                if (valid && rank < need) atomicOr(MASK + (size_t)(m0t + q) * 512 + (ki >> 5), 1u << (ki & 31)); }
        }
        __syncthreads();
    }
#undef IX_LOADA
}

typedef int v8i_t __attribute__((ext_vector_type(8)));
typedef int v4i_t __attribute__((ext_vector_type(4)));
__device__ __forceinline__ v8i_t frag8(const LAS unsigned char* p) { const v4i_t a = *(const LAS v4i_t*)p, b = *(const LAS v4i_t*)(p + 1024); return (v8i_t){a[0], a[1], a[2], a[3], b[0], b[1], b[2], b[3]}; }
__device__ __forceinline__ void attn_phase(const Args& a, LAS unsigned char* lds, int tid, int wave, int lane) {
    const bf16* Q = (const bf16*)(a.ws + WS_PROJ + PB_Q * PROJ_STRIDE); const unsigned char* K8 = (const unsigned char*)(a.ws + WS_KF);
    const bf16* AG = (const bf16*)(a.ws + WS_PROJ + PB_AG * PROJ_STRIDE); const unsigned char* V8 = (const unsigned char*)(a.ws + WS_VT);
    const unsigned* MASK = (const unsigned*)(a.ws + WS_MASK); bf16* MIX = (bf16*)(a.ws + WS_H);
    const int qi = lane & 31, hi = lane >> 5;
    constexpr int SC1 = 0x7f7f7f7f;
    constexpr float POFF = 6.0f;
    LAS unsigned* lut = (LAS unsigned*)(lds + 32768);
    if (tid < 16) lut[tid] = ((tid & 1) ? 0xffu : 0u) | ((tid & 2) ? 0xff00u : 0u) | ((tid & 4) ? 0xff0000u : 0u) | ((tid & 8) ? 0xff000000u : 0u);
    __syncthreads();
    for (int it = blockIdx.x; it < 512; it += gridDim.x) {
        const int hd = it & 7, kk = it >> 3; const int qb = (kk < 32) ? kk : (95 - kk);
        const int q0 = 256 * qb + 32 * wave; const int Lw = 64 * ((q0 >> 6) + 1); const int nT = 4 * (qb + 1);
        v8i_t bq[2];
#pragma unroll
        for (int ks = 0; ks < 2; ++ks) { const v4u* qp = (const v4u*)(Q + (size_t)(q0 + qi) * 1024 + hd * 128 + 64 * ks + 32 * hi);
#pragma unroll
            for (int c4 = 0; c4 < 4; ++c4) { float f[8]; unpack8(qp[c4], f); int t_;
                t_ = __builtin_amdgcn_cvt_pk_fp8_f32(f[0], f[1], 0, false); t_ = __builtin_amdgcn_cvt_pk_fp8_f32(f[2], f[3], t_, true); bq[ks][2 * c4] = t_;
                t_ = __builtin_amdgcn_cvt_pk_fp8_f32(f[4], f[5], 0, false); t_ = __builtin_amdgcn_cvt_pk_fp8_f32(f[6], f[7], t_, true); bq[ks][2 * c4 + 1] = t_; } }
        f32x16 o[4];
#pragma unroll
        for (int db = 0; db < 4; ++db)
#pragma unroll
            for (int t = 0; t < 16; ++t) o[db][t] = 0.f;
        f32x16 osum, cneg;
#pragma unroll
        for (int t = 0; t < 16; ++t) { osum[t] = 0.f; cneg[t] = 60.5f - 4.0f * POFF; }
        asm volatile("" : "+v"(cneg));
        const v8i_t ones8 = {0x38383838, 0x38383838, 0x38383838, 0x38383838, 0x38383838, 0x38383838, 0x38383838, 0x38383838};
        const unsigned long long* mrow8 = (const unsigned long long*)(MASK + (size_t)(q0 + qi) * 512);
        const v4u* kg = (const v4u*)(K8 + (size_t)hd * 512 * 4096) + tid;
        const v4u* vg = (const v4u*)(V8 + (size_t)hd * 256 * 8192) + tid;
#define AT_ITER(T_, RK, RV, MWC) do { const int Tc = (T_); \
            LAS unsigned char* buf = lds + (Tc & 1) * 16384; \
            *(LAS v4u*)(buf + tid * 16) = RK; *(LAS v4u*)(buf + 8192 + tid * 16) = RV; \
            const unsigned long long mw = MWC; \
            __syncthreads(); \
            if (Tc + 2 < nT) { RK = kg[(Tc + 2) * 512]; RV = vg[(Tc + 2) * 512]; MWC = mrow8[Tc + 2]; } \
            if (64 * Tc < Lw) { \
                f32x16 S[2]; \
                _Pragma("unroll") for (int st = 0; st < 2; ++st) { const LAS unsigned char* kb = buf + st * 4096 + lane * 16; \
                    f32x16 c0 = __builtin_amdgcn_mfma_scale_f32_32x32x64_f8f6f4(frag8(kb), bq[0], cneg, 0, 0, 0, SC1, 0, SC1); \
                    S[st] = __builtin_amdgcn_mfma_scale_f32_32x32x64_f8f6f4(frag8(kb + 2048), bq[1], c0, 0, 0, 0, SC1, 0, SC1); } \
                v8i_t pb; \
                _Pragma("unroll") for (int st = 0; st < 2; ++st) { \
                    const unsigned mw32 = st ? (unsigned)(mw >> 32) : (unsigned)mw; \
                      \
                      \
                    const unsigned mwh = mw32 >> (8 * hi); \
                    _Pragma("unroll") for (int i4 = 0; i4 < 4; ++i4) { unsigned t_ = __builtin_amdgcn_cvt_pk_u8_f32(S[st][4 * i4], 0u, 0u); t_ = __builtin_amdgcn_cvt_pk_u8_f32(S[st][4 * i4 + 1], 1u, t_); \
                        t_ = __builtin_amdgcn_cvt_pk_u8_f32(S[st][4 * i4 + 2], 2u, t_); t_ = __builtin_amdgcn_cvt_pk_u8_f32(S[st][4 * i4 + 3], 3u, t_); \
                        const unsigned nib_ = __builtin_amdgcn_ubfe(mwh, 4 * (i4 & 1) + 16 * (i4 >> 1), 4); \
                        pb[4 * st + i4] = (int)(t_ & lut[nib_]); } \
                } \
                _Pragma("unroll") for (int db = 0; db < 4; ++db) o[db] = __builtin_amdgcn_mfma_scale_f32_32x32x64_f8f6f4(frag8(buf + 8192 + db * 2048 + lane * 16), pb, o[db], 0, 1, 0, SC1, 0, SC1); \
                osum = __builtin_amdgcn_mfma_scale_f32_32x32x64_f8f6f4(ones8, pb, osum, 0, 1, 0, SC1, 0, SC1); \
            } } while (0)
        v4u rkA = kg[0], rvA = vg[0], rkB = kg[512], rvB = vg[512];
        unsigned long long mwA = mrow8[0], mwB = mrow8[1];
        for (int T = 0; T < nT; T += 2) { AT_ITER(T, rkA, rvA, mwA); AT_ITER(T + 1, rkB, rvB, mwB); }
#undef AT_ITER
        const float inv = osum[0] > 0.f ? 1.0f / osum[0] : 0.f;
        const size_t m = (size_t)(q0 + qi);
#pragma unroll
        for (int db = 0; db < 4; ++db)
#pragma unroll
            for (int tq = 0; tq < 4; tq += 2) { v2u pk[2];
#pragma unroll
                for (int k2 = 0; k2 < 2; ++k2) { const int d0 = hd * 128 + 32 * db + 8 * (tq + k2) + 4 * hi; const int t0_ = 4 * (tq + k2);
                    const v2u g = *(const v2u*)(AG + m * 1024 + d0);
                    const float y0 = o[db][t0_ + 0] * inv * siluf_(bflo(g.x)), y1 = o[db][t0_ + 1] * inv * siluf_(bfhi(g.x));
                    const float y2 = o[db][t0_ + 2] * inv * siluf_(bflo(g.y)), y3 = o[db][t0_ + 3] * inv * siluf_(bfhi(g.y));
                    pk[k2].x = pk2(y0, y1); pk[k2].y = pk2(y2, y3); }
                auto rx = __builtin_amdgcn_permlane32_swap(pk[0].x, pk[1].x, false, false); auto ry = __builtin_amdgcn_permlane32_swap(pk[0].y, pk[1].y, false, false);
                v4u w; w.x = rx[0]; w.y = ry[0]; w.z = rx[1]; w.w = ry[1];
                *(v4u*)(MIX + m * DM + hd * 128 + 32 * db + 8 * tq + 8 * hi) = w; }
    }
}

constexpr int G8_RS = 144, G8_OP = 256 * G8_RS, G8_STAGE = 2 * G8_OP;
static_assert(2 * G8_STAGE <= LDS_BARST, "fp8 GEMM LDS");
__device__ __forceinline__ v8i_t g8_frag(const LAS unsigned char* p) { const v4i_t a = *(const LAS v4i_t*)p, b = *(const LAS v4i_t*)(p + 16); return (v8i_t){a[0], a[1], a[2], a[3], b[0], b[1], b[2], b[3]}; }
struct SkipOrder {
    pg8::StaticOrder S; int lo;
    __device__ __forceinline__ bool next(int i, pg8::Unit& u) const { if (!S.next(i, u)) return false; if (u.pn >= lo) u.pn += 4; return true; }
    __device__ __forceinline__ void a_ready(const pg8::Unit&) const {}
    __device__ __forceinline__ void done(const pg8::Unit&) const {}
};
template <bool VT>
__device__ __forceinline__ void g8_phase(const Args& a, LAS unsigned char* lds, int tid, int wave, int lane) {
    const unsigned char* H8 = (const unsigned char*)(a.ws + WS_H8); const unsigned char* W8 = (const unsigned char*)(a.ws + WS_W8);
    bf16* PROJ = (bf16*)(a.ws + WS_PROJ); unsigned char* V8 = (unsigned char*)(a.ws + WS_VT);
    const int r = lane & 31, hi = lane >> 5, wr = wave >> 2, wc = wave & 3;
    constexpr int SC1 = 0x7f7f7f7f, SCW = 0x7a7a7a7a;
    const int srow = (tid >> 3) & 63, spiece = tid & 7;
    const int soff0 = srow * DM + spiece * 16, doff0 = srow * G8_RS + spiece * 16;
#define G8_SOFF(i) (soff0 + ((i) & 3) * 64 * DM)
#define G8_DOFF(i) (((i) >> 2) * G8_OP + doff0 + ((i) & 3) * 64 * G8_RS)
    const bool bal = VT && gridDim.x == 256;
    const int nti = (VT ? 4 : 12 + (FP8_HG ? 4 : 0)) * (SEQ / 256);
    for (int k0 = 0; ; ++k0) {
        int it;
        if (bal) { const int w = (int)blockIdx.x; if (w < 64 || k0 > 1 || (k0 == 1 && w >= 128)) break; it = (k0 == 0) ? (w - 64) : (192 + w - 64); }
        else { it = (int)blockIdx.x + k0 * (int)gridDim.x; if (it >= nti) break; }
        const int pm = it & 63; int pn = it >> 6; if (VT) pn += 8; else if (pn >= 8) pn += 4;
        const unsigned char* Ag = H8 + (size_t)(256 * pm) * DM; const unsigned char* Bg = W8 + (size_t)(256 * pn) * DM;
        constexpr bool vt = VT;
        f32x16 acc[4][2];
#pragma unroll
        for (int mt = 0; mt < 4; ++mt)
#pragma unroll
            for (int nt = 0; nt < 2; ++nt)
#pragma unroll
                for (int t = 0; t < 16; ++t) acc[mt][nt][t] = 0.f;
        v4u rg[8];
#pragma unroll
        for (int i = 0; i < 8; ++i) rg[i] = *(const v4u*)((i < 4 ? Ag : Bg) + G8_SOFF(i));
        for (int ks = 0; ks < DM / 128; ++ks) {
            LAS unsigned char* buf = lds + (ks & 1) * G8_STAGE;
#pragma unroll
            for (int i = 0; i < 8; ++i) *(LAS v4u*)(buf + G8_DOFF(i)) = rg[i];
            __syncthreads();
            if (ks + 1 < DM / 128) {
#pragma unroll
                for (int i = 0; i < 8; ++i) rg[i] = *(const v4u*)((i < 4 ? Ag : Bg) + G8_SOFF(i) + 128 * (ks + 1)); }
            const LAS unsigned char* tokp = buf + (128 * wr + r) * G8_RS + 32 * hi;
            const LAS unsigned char* wgtp = buf + G8_OP + (64 * wc + r) * G8_RS + 32 * hi;
#pragma unroll
            for (int kk = 0; kk < 2; ++kk) {
                v8i_t fw[2];
#pragma unroll
                for (int nt = 0; nt < 2; ++nt) fw[nt] = g8_frag(wgtp + nt * 32 * G8_RS + 64 * kk);
#pragma unroll
                for (int mt = 0; mt < 4; ++mt) { const v8i_t ft = g8_frag(tokp + mt * 32 * G8_RS + 64 * kk);
                    if (vt) {
#pragma unroll
                        for (int nt = 0; nt < 2; ++nt) acc[mt][nt] = __builtin_amdgcn_mfma_scale_f32_32x32x64_f8f6f4(ft, fw[nt], acc[mt][nt], 0, 0, 0, SC1, 0, SCW);
                    } else {
#pragma unroll
                        for (int nt = 0; nt < 2; ++nt) acc[mt][nt] = __builtin_amdgcn_mfma_scale_f32_32x32x64_f8f6f4(fw[nt], ft, acc[mt][nt], 0, 0, 0, SCW, 0, SC1);
                    } }
            }
        }
        if (vt) {
#pragma unroll
            for (int nt = 0; nt < 2; ++nt) { const int R = 256 * (pn - 8) + 64 * wc + 32 * nt + r; const int hd = R >> 7, db = (R & 127) >> 5;
#pragma unroll
                for (int mt = 0; mt < 4; ++mt) { const int blk = 4 * pm + 2 * wr + (mt >> 1);
                    unsigned char* base = V8 + ((((size_t)(hd * 256 + blk) * 4 + db) * 2 + (mt & 1)) * 64 + r) * 16 + 4 * hi;
#pragma unroll
                    for (int tq = 0; tq < 4; ++tq) { int t_ = __builtin_amdgcn_cvt_pk_fp8_f32(acc[mt][nt][4 * tq], acc[mt][nt][4 * tq + 1], 0, false); t_ = __builtin_amdgcn_cvt_pk_fp8_f32(acc[mt][nt][4 * tq + 2], acc[mt][nt][4 * tq + 3], t_, true);
                        *(unsigned*)(base + (tq & 1) * 32 * 16 + 8 * (tq >> 1)) = (unsigned)t_; } } }
        } else {
            const int bufi = pn < 4 ? PB_Q : (pn < 8 ? PB_K : (pn < 16 ? PB_AG : PB_RQ + FP8_HG - 1));
            bf16* ob = PROJ + (size_t)bufi * (PROJ_STRIDE / 2) + 256 * (pn & 3) + 64 * wc + 8 * hi;
#pragma unroll
            for (int mt = 0; mt < 4; ++mt) { bf16* orow = ob + (size_t)(256 * pm + 128 * wr + 32 * mt + r) * 1024;
#pragma unroll
                for (int nt = 0; nt < 2; ++nt)
#pragma unroll
                    for (int tq = 0; tq < 4; tq += 2) {
                        unsigned ax = pk2(acc[mt][nt][4 * tq], acc[mt][nt][4 * tq + 1]), ay = pk2(acc[mt][nt][4 * tq + 2], acc[mt][nt][4 * tq + 3]);
                        unsigned bx = pk2(acc[mt][nt][4 * tq + 4], acc[mt][nt][4 * tq + 5]), by = pk2(acc[mt][nt][4 * tq + 6], acc[mt][nt][4 * tq + 7]);
                        auto rx = __builtin_amdgcn_permlane32_swap(ax, bx, false, false); auto ry = __builtin_amdgcn_permlane32_swap(ay, by, false, false);
                        v4u w; w.x = rx[0]; w.y = ry[0]; w.z = rx[1]; w.w = ry[1];
                        *(v4u*)(orow + 32 * nt + 8 * tq) = w; } }
        }
        __syncthreads();
    }
}

#define XB_TMO      128
#define XB_XCNT(j)  (256  + 64 * (j))
#define XB_XSUB(j)  (1280 + 64 * (j))
#define XB_XGEN(j)  (2304 + 64 * (j))
#define XB_TOP      3328
#define XB_TOPGEN   3392
#define XCD_BAR_WORDS 3456
#define XB_SPIN_CAP (1u << 18)

__device__ __forceinline__ unsigned xb_ld(unsigned* p)              { return __hip_atomic_load(p, __ATOMIC_RELAXED, __HIP_MEMORY_SCOPE_AGENT); }
__device__ __forceinline__ unsigned xb_add(unsigned* p, unsigned v) { return __hip_atomic_fetch_add(p, v, __ATOMIC_RELAXED, __HIP_MEMORY_SCOPE_AGENT); }
__device__ __forceinline__ unsigned xb_xcc_id() { return (unsigned)__builtin_amdgcn_s_getreg((3 << 11) | 20) & 0xFu; }
#define XB_SPIN(cond, bar) do { unsigned _sp = 0; while (cond) { __builtin_amdgcn_s_sleep(1); \
    if ((++_sp & 255u) == 0u) { if (xb_ld(&(bar)[XB_TMO])) break; if (_sp > XB_SPIN_CAP) { atomicAdd(&(bar)[XB_TMO], 1u); break; } } } } while (0)

struct XcdBarrier {
    unsigned* bar; unsigned x;
    volatile LAS unsigned* st;
};

__device__ __forceinline__ XcdBarrier xcd_barrier_post(unsigned* bar, volatile LAS unsigned* st) {
    XcdBarrier b; b.bar = bar; b.x = xb_xcc_id(); b.st = st;
    if (threadIdx.x == 0) (void)xb_add(&bar[XB_XCNT(b.x)], 1u);
    return b;
}
__device__ __forceinline__ void xcd_barrier_complete(unsigned* bar, unsigned x, unsigned& nloc, unsigned& nx) {
    const unsigned G = gridDim.x * gridDim.y * gridDim.z;
    unsigned sum, cnt, mine, sp = 0u;
    for (;;) {
        sum = 0u; cnt = 0u; mine = 0u;
#pragma unroll
        for (unsigned j = 0; j < 16; ++j) { const unsigned c = xb_ld(&bar[XB_XCNT(j)]); sum += c; cnt += (c > 0u) ? 1u : 0u; mine = (j == x) ? c : mine; }
        if (sum == G) break;
        __builtin_amdgcn_s_sleep(1);
        if ((++sp & 255u) == 0u) { if (xb_ld(&bar[XB_TMO])) break; if (sp > XB_SPIN_CAP) { atomicAdd(&bar[XB_TMO], 1u); break; } }
    }
    nloc = mine > 0u ? mine : 1u; nx = cnt > 0u ? cnt : 1u;
}

__device__ __forceinline__ void xcd_barrier(const XcdBarrier& b) {
    asm volatile("s_waitcnt vmcnt(0)" ::: "memory");
    __syncthreads();
    if (threadIdx.x == 0) {
        unsigned* bar = b.bar;
        __builtin_amdgcn_s_waitcnt(0);
        unsigned nloc = b.st[0], nx = b.st[1];
        if (nloc == 0u) { xcd_barrier_complete(bar, b.x, nloc, nx); b.st[0] = nloc; b.st[1] = nx; }
        const unsigned old = xb_add(&bar[XB_XSUB(b.x)], 1u);
        const unsigned gen = old / nloc;
        if (old + 1u == (gen + 1u) * nloc) {
            __builtin_amdgcn_fence(__ATOMIC_RELEASE, "agent");
            asm volatile("s_waitcnt vmcnt(0)" ::: "memory");
            const unsigned og = xb_add(&bar[XB_TOP], 1u);
            const unsigned tg = og / nx;
            if (og + 1u == (tg + 1u) * nx) xb_add(&bar[XB_TOPGEN], 1u);
            else XB_SPIN(xb_ld(&bar[XB_TOPGEN]) == tg, bar);
            __builtin_amdgcn_fence(__ATOMIC_ACQUIRE, "agent");
            xb_add(&bar[XB_XGEN(b.x)], 1u);
            asm volatile("s_waitcnt vmcnt(0)" ::: "memory");
        } else {
            XB_SPIN(xb_ld(&bar[XB_XGEN(b.x)]) == gen, bar);
            __builtin_amdgcn_fence(__ATOMIC_ACQUIRE, "agent");
            asm volatile("s_waitcnt vmcnt(0)" ::: "memory");
        }
    }
    __syncthreads();
}

__global__ void __launch_bounds__(NTHR, 2) mk_fwd(Args a) {
    extern __shared__ __attribute__((aligned(16))) unsigned char lds_raw[];
    LAS unsigned char* lds = (LAS unsigned char*)lds_raw;
    const int tid = threadIdx.x, lane = tid & 63, wave = __builtin_amdgcn_readfirstlane(tid >> 6);
    const int lo = a.ph_lo, hi = a.ph_hi;
#define IN(k) (lo <= (k) && (k) < hi)
    if (tid < 16) ((LAS unsigned*)(lds + LDS_BARST))[tid] = 0u;
    __syncthreads();
    XcdBarrier gbar = xcd_barrier_post((unsigned*)(a.ws + WS_CTL + CTL_BAR_OFF + (size_t)a.bar_region * 16384), (volatile LAS unsigned*)(lds + LDS_BARST));
#define SEAM(k) do { if (IN(k) && IN((k) + 1)) { xcd_barrier(gbar); } } while (0)
#ifdef PROBE_SYNCS
    for (int i = 0; i < PROBE_SYNCS; ++i) xcd_barrier(gbar);
#endif
    if (IN(0)) { for (int rep = 0; rep < REP_P0; ++rep) { phase0(a, lds, tid, wave, lane, rep == 0); __syncthreads(); } }
    SEAM(0);
    if (IN(1)) { for (int rep = 0; rep < REP_P01; ++rep) phase1(a, wave, lane); }
    SEAM(1);
    if (IN(2)) for (int rep = 0; rep < REP_GEMM; ++rep) {
        {
            pg8::Gemm g{(const pg8::bf16_t*)(a.ws + WS_H), (const pg8::bf16_t*)(a.ws + WS_WIN), SEQ, NPROJ, DM}; SkipOrder S; S.S.init(SEQ, NPROJ - (FP8_HG ? 1024 : 0), gridDim.x, (int)blockIdx.x);
            S.lo = FP8_HG ? 4 * FP8_HG : 1 << 20;
            pg8::EpiProj E{(pg8::bf16_t*)(a.ws + WS_PROJ) + (size_t)PB_QI * (PROJ_STRIDE / 2), PROJ_STRIDE / 2, (float*)(a.ws + WS_TAIL)};
            pg8::gemm_phase<pg8::EpiProj, SkipOrder, true, true>(lds, g, S, E);
        }
        __syncthreads();
        g8_phase<false>(a, lds, tid, wave, lane);
        g8_phase<true>(a, lds, tid, wave, lane);
    }
    SEAM(2);
    if (IN(3)) {
        phase3_post(a, wave, lane);
        for (int rep = 0; rep < REP_HG; ++rep) for (int u = blockIdx.x; u < BH * HG_NG; u += gridDim.x) { hgrn_unit<false>(a, lds, u & 7, u >> 3, tid, wave, lane); __syncthreads(); }
    }
    SEAM(3);
    if (IN(4)) {
#ifdef MK_DUP_PHASE
        if (lo != 4)
#endif
        hgrn_scan(a, tid);
        for (int rep = 0; rep < REP_IDX; ++rep) indexer_phase(a, lds, tid, wave, lane);
    }
    SEAM(4);
    if (IN(5)) {
        for (int rep = 0; rep < REP_ATT; ++rep) attn_phase(a, lds, tid, wave, lane);
        __syncthreads();
        for (int rep = 0; rep < REP_HG; ++rep) for (int u = blockIdx.x; u < BH * HG_NG; u += gridDim.x) { hgrn_unit<true>(a, lds, u & 7, u >> 3, tid, wave, lane); __syncthreads(); }
    }
    SEAM(5);
    if (IN(6)) for (int rep = 0; rep < REP_OUT; ++rep) {
        pg8::Gemm g{(const pg8::bf16_t*)(a.ws + WS_H), (const pg8::bf16_t*)(a.ws + WS_WOUT), SEQ, DM, DM}; pg8::StaticOrder S; S.init(SEQ, DM, gridDim.x, (int)blockIdx.x);
        pg8::EpiOut E{a.x, (const float*)(a.ws + WS_CTL) + 2 * DM, a.out, DM};
        pg8::gemm_phase<pg8::EpiOut, pg8::StaticOrder, true, true>(lds, g, S, E);
    }
#undef IN
#undef SEAM
}

extern "C" void kernel_launch(void* const* d_in, const int* in_sizes, int n_in, void* d_out, int out_size, void* d_ws, size_t ws_size, hipStream_t stream) {
    static int grid = 0;
    if (grid == 0) {
        int dev = 0, cus = 0, per_cu = 0;
        if (n_in != 13 || out_size != SEQ * DM || ws_size < WS_END) { fprintf(stderr, "kernel_launch: unexpected shapes (n_in %d out %d ws %zu)\n", n_in, out_size, ws_size); grid = -1; return; }
        hipGetDevice(&dev); hipDeviceGetAttribute(&cus, hipDeviceAttributeMultiprocessorCount, dev);
        hipFuncSetAttribute((const void*)mk_fwd, hipFuncAttributeMaxDynamicSharedMemorySize, LDS_BYTES);
        hipOccupancyMaxActiveBlocksPerMultiprocessor(&per_cu, (const void*)mk_fwd, NTHR, LDS_BYTES);
        if (per_cu < 1) { fprintf(stderr, "kernel_launch: occupancy query says %d blocks per CU\n", per_cu); per_cu = 1; }
        (void)hipGetLastError();
        grid = cus;
    }
    if (grid < 0) return;
    hipMemsetAsync((char*)d_ws + WS_CTL, 0, CTL_ZERO_BYTES, stream);
    Args a;
    memset(&a, 0, sizeof(a));
    a.x = (const float*)d_in[0]; a.c = (const float*)d_in[1]; a.pos = (const int*)d_in[2]; a.ada_w = (const float*)d_in[3]; a.ada_b = (const float*)d_in[4];
    a.norm_g = (const float*)d_in[5]; a.w_in = (const float*)d_in[6]; a.q_norm_g = (const float*)d_in[7]; a.k_norm_g = (const float*)d_in[8]; a.ik_norm_g = (const float*)d_in[9];
    a.lb_logits = (const float*)d_in[10]; a.hgrn_norm_g = (const float*)d_in[11]; a.w_out = (const float*)d_in[12];
    a.out = (float*)d_out; a.ws = (unsigned char*)d_ws;
    for (int d = 0; d < 64; ++d) a.invf_a[d] = (float)std::pow(10000.0, -(double)d / 64.0);
    for (int d = 0; d < 32; ++d) a.invf_i[d] = (float)std::pow(10000.0, -(double)d / 32.0);
#if MK_N_LAUNCHES == 1
#ifdef MK_DUP_PHASE
    {
        void* args[] = {&a};
        a.ph_lo = 0; a.ph_hi = MK_DUP_PHASE + 1;
        (void)hipLaunchCooperativeKernel((const void*)mk_fwd, dim3(grid), dim3(NTHR), args, LDS_BYTES, stream);
        a.ph_lo = MK_DUP_PHASE; a.ph_hi = N_PHASES; a.bar_region = 1;
        (void)hipLaunchCooperativeKernel((const void*)mk_fwd, dim3(grid), dim3(NTHR), args, LDS_BYTES, stream);
    }
#else
    a.ph_lo = 0; a.ph_hi = N_PHASES;
    void* args[] = {&a};
    hipError_t e = hipLaunchCooperativeKernel((const void*)mk_fwd, dim3(grid), dim3(NTHR), args, LDS_BYTES, stream);
    if (e != hipSuccess) fprintf(stderr, "kernel_launch: cooperative launch failed: %s (grid %d)\n", hipGetErrorString(e), grid);
#endif
#else
    for (int p = 0; p < N_PHASES; ++p) { a.ph_lo = p; a.ph_hi = p + 1; hipLaunchKernelGGL(mk_fwd, dim3(grid), dim3(NTHR), LDS_BYTES, stream, a); }
#endif
}
```

```cpp
#include <hip/hip_runtime.h>
#include <hip/hip_cooperative_groups.h>
#include <cstdio>
#include <cstdint>
#include <cmath>
#include <cstring>
namespace cg = cooperative_groups;
namespace pg8 {
#define PG8_LAS __attribute__((address_space(3)))
typedef unsigned short bf16_t;
typedef short bf16x8 __attribute__((ext_vector_type(8)));
typedef float f32x4 __attribute__((ext_vector_type(4)));
typedef unsigned u32x4 __attribute__((ext_vector_type(4)));
constexpr int BM = 256, BK = 64, HALF = 128, HTB = HALF * BK * 2  , STAGE_BYTES = 8 * HTB, NXCD = 8, WGM = 8;

__host__ __device__ __forceinline__ int lds_byte(int r, int c) { const int st = (r >> 4) * 2 + (c >> 5), rr = r & 15, cc = c & 31, ob = rr * 64 + cc * 2; return st * 1024 + (ob ^ (((ob >> 9) & 1) << 5)); }
__host__ __device__ __forceinline__ void stage_rc(int b, int& R, int& C) { const int st = b / 1024, sb = b % 1024, swz = sb ^ (((sb >> 9) & 1) << 5); R = (st >> 1) * 16 + swz / 64; C = (st & 1) * 32 + (swz % 64) / 2; }
__host__ __device__ __forceinline__ int perm32(int rho) { const int n = rho >> 4, i = rho & 15; return 8 * (i >> 2) + 4 * n + (i & 3); }

struct Unit { int pm, pn; };
struct Gemm { const bf16_t* A; const bf16_t* Bt; int M, N, K; };

struct StaticOrder {
    int nM, nN, nwg, G, c;
    __host__ __device__ void init(int M, int N, int G_, int c_) { nM = M / BM; nN = N / BM; nwg = nM * nN; G = G_; c = c_; }
    __host__ __device__ bool next(int i, Unit& u) const {
        const long L = (long)i * G + c; if (L >= nwg) return false;
        int wgid = (int)L; { const int q = nwg / NXCD, r = nwg % NXCD, xcd = wgid % NXCD, off = wgid / NXCD; wgid = (xcd < r ? xcd * (q + 1) : r * (q + 1) + (xcd - r) * q) + off; }
        const int nig = WGM * nN, gid = wgid / nig, fm = gid * WGM, gsz = (nM - fm) < WGM ? (nM - fm) : WGM;
        u.pm = fm + ((wgid % nig) % gsz); u.pn = (wgid % nig) / gsz; return true;
    }
    __device__ __forceinline__ void a_ready(const Unit&) const {}
    __device__ __forceinline__ void done(const Unit&) const {}
};

__device__ __forceinline__ unsigned cvt_pk_bf16(float lo, float hi) { unsigned r; asm volatile("v_cvt_pk_bf16_f32 %0, %1, %2" : "=v"(r) : "v"(lo), "v"(hi)); return r; }
typedef float f32x2 __attribute__((ext_vector_type(2)));
typedef float f32x2 __attribute__((ext_vector_type(2)));
struct EpiBf16 {
    static constexpr bool PERM = true, AFTER_DRAIN = false;
    bf16_t* O; int ldc;
    __device__ __forceinline__ void operator()(const f32x4 (&acc)[2][2][4][2], const Unit& u, int wr, int wc, int fr, int fq) const {
        const int row0 = u.pm * BM + wr * 64 + fr; const int col0 = u.pn * BM + wc * 32 + 8 * fq;
#pragma unroll
        for (int ai = 0; ai < 2; ++ai)
#pragma unroll
            for (int m = 0; m < 4; ++m) { bf16_t* rowp = O + (size_t)(row0 + ai * HALF + m * 16) * ldc + col0;
#pragma unroll
                for (int bj = 0; bj < 2; ++bj) { const f32x4 v0 = acc[ai][bj][m][0], v1 = acc[ai][bj][m][1];
                    u32x4 w; w.x = cvt_pk_bf16(v0[0], v0[1]); w.y = cvt_pk_bf16(v0[2], v0[3]); w.z = cvt_pk_bf16(v1[0], v1[1]); w.w = cvt_pk_bf16(v1[2], v1[3]);
                    *(u32x4*)(rowp + bj * HALF) = w; } }
    }
};
struct EpiVT {
    static constexpr bool PERM = true, AFTER_DRAIN = false;
    unsigned char* O;
    __device__ __forceinline__ void operator()(const f32x4 (&acc)[2][2][4][2], const Unit& u, int wr, int wc, int fr, int fq) const {
        const int row0 = u.pm * BM + wr * 64 + fr;
#pragma unroll
        for (int ai = 0; ai < 2; ++ai)
#pragma unroll
            for (int m = 0; m < 4; ++m) { const int R = row0 + ai * HALF + m * 16; const int hd = R >> 7, dim = R & 127;
#pragma unroll
                for (int bj = 0; bj < 2; ++bj) { const f32x4 v0 = acc[ai][bj][m][0], v1 = acc[ai][bj][m][1];
                    const int blk = u.pn * 4 + bj * 2 + (wc >> 1);
                    int t_; unsigned lo, hi;
                    t_ = __builtin_amdgcn_cvt_pk_fp8_f32(v0[0], v0[1], 0, false); t_ = __builtin_amdgcn_cvt_pk_fp8_f32(v0[2], v0[3], t_, true); lo = (unsigned)t_;
                    t_ = __builtin_amdgcn_cvt_pk_fp8_f32(v1[0], v1[1], 0, false); t_ = __builtin_amdgcn_cvt_pk_fp8_f32(v1[2], v1[3], t_, true); hi = (unsigned)t_;
                    unsigned long long w = (unsigned long long)lo | ((unsigned long long)hi << 32);
                    *(unsigned long long*)(O + ((((size_t)(hd * 256 + blk) * 4 + (dim >> 5)) * 2 + (wc & 1)) * 64 + (fq & 1) * 32 + (dim & 31)) * 16 + 8 * (fq >> 1)) = w; } }
    }
};
struct EpiProj {
    static constexpr bool PERM = true, AFTER_DRAIN = false;
    bf16_t* O; size_t stride; float* tail;
    __device__ __forceinline__ void operator()(const f32x4 (&acc)[2][2][4][2], const Unit& u, int wr, int wc, int fr, int fq) const {
        const int row0 = u.pm * BM + wr * 64 + fr; const int colt = u.pn * BM; const int t = colt >> 10;
        if (t < 5) {
            bf16_t* base = O + (size_t)t * stride; const int col0 = (colt & 1023) + wc * 32 + 8 * fq;
#pragma unroll
            for (int ai = 0; ai < 2; ++ai)
#pragma unroll
                for (int m = 0; m < 4; ++m) { bf16_t* rowp = base + (size_t)(row0 + ai * HALF + m * 16) * 1024 + col0;
#pragma unroll
                    for (int bj = 0; bj < 2; ++bj) { const f32x4 v0 = acc[ai][bj][m][0], v1 = acc[ai][bj][m][1];
                        u32x4 w; w.x = cvt_pk_bf16(v0[0], v0[1]); w.y = cvt_pk_bf16(v0[2], v0[3]); w.z = cvt_pk_bf16(v1[0], v1[1]); w.w = cvt_pk_bf16(v1[2], v1[3]);
                        *(u32x4*)(rowp + bj * HALF) = w; } }
        } else {
            const int col0 = wc * 32 + 8 * fq;
#pragma unroll
            for (int ai = 0; ai < 2; ++ai)
#pragma unroll
                for (int m = 0; m < 4; ++m) { float* rp = tail + (size_t)(row0 + ai * HALF + m * 16) * 128 + col0;
                    *(f32x4*)(rp) = acc[ai][0][m][0]; *(f32x4*)(rp + 4) = acc[ai][0][m][1]; }
        }
    }
};
struct EpiOut {
    static constexpr bool PERM = true, AFTER_DRAIN = false;
    const float* x; const float* gate; float* out; int ldc;
    __device__ __forceinline__ void operator()(const f32x4 (&acc)[2][2][4][2], const Unit& u, int wr, int wc, int fr, int fq) const {
        const int row0 = u.pm * BM + wr * 64 + fr; const int col0 = u.pn * BM + wc * 32 + 8 * fq;
        f32x4 gv[2][2];
#pragma unroll
        for (int bj = 0; bj < 2; ++bj)
#pragma unroll
            for (int n = 0; n < 2; ++n) gv[bj][n] = *(const f32x4*)(gate + col0 + bj * HALF + 4 * n);
#pragma unroll
        for (int ai = 0; ai < 2; ++ai)
#pragma unroll
            for (int m = 0; m < 4; ++m) { const size_t off = (size_t)(row0 + ai * HALF + m * 16) * ldc + col0;
#pragma unroll
                for (int bj = 0; bj < 2; ++bj)
#pragma unroll
                    for (int n = 0; n < 2; ++n) { const f32x4 xv = *(const f32x4*)(x + off + bj * HALF + 4 * n);
                        *(f32x4*)(out + off + bj * HALF + 4 * n) = xv + gv[bj][n] * acc[ai][bj][m][n]; } }
    }
};

template <class Epi, class Sched, bool ALIGN_EPI = false, bool SP2 = false>
__device__ __forceinline__ void gemm_phase(PG8_LAS unsigned char* lds, const Gemm g, const Sched& S, const Epi& E) {
    const int tid = threadIdx.x, wid = __builtin_amdgcn_readfirstlane(tid >> 6), lane = tid & 63, wr = wid >> 2, wc = wid & 3, fr = lane & 15, fq = lane >> 4;
    const int K = g.K, nt = K / BK;
    unsigned voffA[2], voffB[2];
#pragma unroll
    for (int i = 0; i < 2; ++i) { int R, C; stage_rc(tid * 16 + i * 8192, R, C); const int Rb = Epi::PERM ? ((R & ~31) + perm32(R & 31)) : R;
        voffA[i] = (unsigned)(R * K + C) * 2u; voffB[i] = (unsigned)(Rb * K + C) * 2u; }
    const size_t kstep = (size_t)(BK * 2);
    const size_t hstep = (size_t)HALF * K * 2;
    const size_t tstep = 2 * hstep;
    const unsigned ldsw = (unsigned)wid * 1024u;
    const int aoff = lds_byte(wr * 64 + fr, fq * 8), boff = lds_byte(wc * 32 + fr, fq * 8);
#define PG8_SA(b, h) (((b) * 2 + (h)) * HTB)
#define PG8_SB(b, h) ((4 + (b) * 2 + (h)) * HTB)
#define PG8_STAGE(bufoff, gbase, voff) do { _Pragma("unroll") for (int _i = 0; _i < 2; ++_i) \
        __builtin_amdgcn_global_load_lds((const unsigned*)((const char*)(gbase) + (voff)[_i]), (PG8_LAS unsigned*)(lds + (bufoff) + ldsw + _i * 8192), 16, 0, 0); } while (0)
#define PG8_LDA(dst, b, h) do { _Pragma("unroll") for (int m = 0; m < 4; ++m) _Pragma("unroll") for (int k = 0; k < 2; ++k) dst[m][k] = *(const PG8_LAS bf16x8*)(lds + PG8_SA(b, h) + aoff + m * 2048 + k * 1024); } while (0)
#define PG8_LDB(dst, b, h) do { _Pragma("unroll") for (int n = 0; n < 2; ++n) _Pragma("unroll") for (int k = 0; k < 2; ++k) dst[n][k] = *(const PG8_LAS bf16x8*)(lds + PG8_SB(b, h) + boff + n * 2048 + k * 1024); } while (0)
#define PG8_MMA(ai, bj, At, Bt) do { __builtin_amdgcn_s_setprio(1); _Pragma("unroll") for (int m = 0; m < 4; ++m) _Pragma("unroll") for (int n = 0; n < 2; ++n) _Pragma("unroll") for (int k = 0; k < 2; ++k) \
        acc[ai][bj][m][n] = __builtin_amdgcn_mfma_f32_16x16x32_bf16(Bt[n][k], At[m][k], acc[ai][bj][m][n], 0, 0, 0); __builtin_amdgcn_s_setprio(0); } while (0)
#define PG8_WAIT_V(n) asm volatile("s_waitcnt vmcnt(" #n ")" ::: "memory")
#define PG8_WAIT_L(n) asm volatile("s_waitcnt lgkmcnt(" #n ")" ::: "memory")
#define PG8_BAR __builtin_amdgcn_s_barrier()
#define PG8_SCHED __builtin_amdgcn_sched_barrier(0)
    Unit cur, nxt; int ui = 0;
    if (!S.next(0, cur)) return;
    f32x4 acc[2][2][4][2];
#pragma unroll
    for (int a = 0; a < 2; ++a)
#pragma unroll
        for (int b = 0; b < 2; ++b)
#pragma unroll
            for (int m = 0; m < 4; ++m)
#pragma unroll
                for (int n = 0; n < 2; ++n) acc[a][b][m][n] = (f32x4){0.f, 0.f, 0.f, 0.f};
    bf16x8 At[4][2], B0[2][2], B1[2][2];
    const char* cA = (const char*)g.A + (size_t)cur.pm * tstep; const char* cB = (const char*)g.Bt + (size_t)cur.pn * tstep;
    S.a_ready(cur);
    if constexpr (SP2) {
        PG8_STAGE(PG8_SB(0, 0), cB, voffB); PG8_STAGE(PG8_SB(0, 1), cB + hstep, voffB); PG8_STAGE(PG8_SA(0, 0), cA, voffA); PG8_STAGE(PG8_SA(0, 1), cA + hstep, voffA);
        if (wr == 1) PG8_BAR;
        PG8_WAIT_V(2); PG8_BAR;
        PG8_STAGE(PG8_SB(1, 0), cB + kstep, voffB); PG8_STAGE(PG8_SA(1, 0), cA + kstep, voffA); PG8_STAGE(PG8_SB(1, 1), cB + hstep + kstep, voffB);
        PG8_WAIT_V(6); PG8_BAR;
    } else {
        PG8_STAGE(PG8_SB(0, 0), cB, voffB); PG8_STAGE(PG8_SA(0, 0), cA, voffA); PG8_STAGE(PG8_SB(0, 1), cB + hstep, voffB); PG8_STAGE(PG8_SA(0, 1), cA + hstep, voffA);
        if (wr == 1) PG8_BAR;
        PG8_WAIT_V(4); PG8_BAR;
        PG8_STAGE(PG8_SB(1, 0), cB + kstep, voffB); PG8_STAGE(PG8_SA(1, 0), cA + kstep, voffA); PG8_STAGE(PG8_SB(1, 1), cB + hstep + kstep, voffB);
        PG8_WAIT_V(6); PG8_BAR;
    }
    for (;;) {
        const bool has_next = S.next(ui + 1, nxt);
        const char* nA = has_next ? (const char*)g.A + (size_t)nxt.pm * tstep : cA; const char* nB = has_next ? (const char*)g.Bt + (size_t)nxt.pn * tstep : cB;
        for (int t = 0; t < nt; t += 2) {
            const bool last = (t == nt - 2);
            const char* a1 = cA + (size_t)(t + 1) * kstep;
            const char* a2 = last ? nA : cA + (size_t)(t + 2) * kstep; const char* b2 = last ? nB : cB + (size_t)(t + 2) * kstep;
            const char* a3 = a2 + kstep; const char* b3 = b2 + kstep;
            if (last && has_next) S.a_ready(nxt);
            if constexpr (SP2) {
            PG8_LDB(B0, 0, 0); PG8_LDB(B1, 0, 1); PG8_SCHED; PG8_LDA(At, 0, 0); PG8_STAGE(PG8_SA(1, 1), a1 + hstep, voffA);
            PG8_WAIT_V(8); PG8_WAIT_L(0); PG8_BAR; PG8_MMA(0, 0, At, B0); PG8_MMA(0, 1, At, B1); PG8_BAR; PG8_SCHED;
            PG8_LDA(At, 0, 1); PG8_STAGE(PG8_SB(0, 0), b2, voffB); PG8_STAGE(PG8_SB(0, 1), b2 + hstep, voffB); PG8_STAGE(PG8_SA(0, 0), a2, voffA);
            PG8_WAIT_V(8); PG8_WAIT_L(0); PG8_BAR; PG8_MMA(1, 0, At, B0); PG8_MMA(1, 1, At, B1); PG8_BAR; PG8_SCHED;
            PG8_LDB(B0, 1, 0); PG8_LDB(B1, 1, 1); PG8_SCHED; PG8_LDA(At, 1, 0); PG8_STAGE(PG8_SA(0, 1), a2 + hstep, voffA);
            PG8_WAIT_V(8); PG8_WAIT_L(0); PG8_BAR; PG8_MMA(0, 0, At, B0); PG8_MMA(0, 1, At, B1); PG8_BAR; PG8_SCHED;
            PG8_LDA(At, 1, 1); PG8_STAGE(PG8_SB(1, 0), b3, voffB); PG8_STAGE(PG8_SB(1, 1), b3 + hstep, voffB); PG8_STAGE(PG8_SA(1, 0), a3, voffA);
            PG8_WAIT_V(8); PG8_WAIT_L(0); PG8_BAR; PG8_MMA(1, 0, At, B0); PG8_MMA(1, 1, At, B1); PG8_BAR; PG8_SCHED;
            } else {
            PG8_LDB(B0, 0, 0); PG8_SCHED; PG8_LDA(At, 0, 0); PG8_STAGE(PG8_SA(1, 1), a1 + hstep, voffA);
            PG8_WAIT_L(8); PG8_BAR; PG8_WAIT_L(0); PG8_MMA(0, 0, At, B0); PG8_BAR; PG8_SCHED;
            PG8_LDB(B1, 0, 1); PG8_STAGE(PG8_SB(0, 0), b2, voffB);
            PG8_BAR; PG8_WAIT_L(0); PG8_MMA(0, 1, At, B1); PG8_BAR;
            PG8_LDA(At, 0, 1); PG8_STAGE(PG8_SA(0, 0), a2, voffA);
            PG8_BAR; PG8_WAIT_L(0); PG8_MMA(1, 0, At, B0); PG8_BAR; PG8_SCHED;
            PG8_STAGE(PG8_SB(0, 1), b2 + hstep, voffB);
            PG8_WAIT_V(6); PG8_BAR; PG8_MMA(1, 1, At, B1); PG8_BAR;
            PG8_LDB(B0, 1, 0); PG8_SCHED; PG8_LDA(At, 1, 0); PG8_STAGE(PG8_SA(0, 1), a2 + hstep, voffA);
            PG8_WAIT_L(8); PG8_BAR; PG8_WAIT_L(0); PG8_MMA(0, 0, At, B0); PG8_BAR; PG8_SCHED;
            PG8_LDB(B1, 1, 1); PG8_STAGE(PG8_SB(1, 0), b3, voffB);
            PG8_BAR; PG8_WAIT_L(0); PG8_MMA(0, 1, At, B1); PG8_BAR;
            PG8_LDA(At, 1, 1); PG8_STAGE(PG8_SA(1, 0), a3, voffA);
            PG8_BAR; PG8_WAIT_L(0); PG8_MMA(1, 0, At, B0); PG8_BAR; PG8_SCHED;
            PG8_STAGE(PG8_SB(1, 1), b3 + hstep, voffB);
            PG8_WAIT_V(6); PG8_BAR; PG8_MMA(1, 1, At, B1); PG8_BAR;
            }
        }
        if constexpr (ALIGN_EPI) { if (wr == 0) PG8_BAR; }
        if constexpr (!Epi::AFTER_DRAIN) { E(acc, cur, wr, wc, fr, fq); S.done(cur); }
        if (!has_next) break;
#pragma unroll
        for (int a = 0; a < 2; ++a)
#pragma unroll
            for (int b = 0; b < 2; ++b)
#pragma unroll
                for (int m = 0; m < 4; ++m)
#pragma unroll
                    for (int n = 0; n < 2; ++n) acc[a][b][m][n] = (f32x4){0.f, 0.f, 0.f, 0.f};
        cur = nxt; cA = nA; cB = nB; ++ui;
        if constexpr (ALIGN_EPI) { if (wr == 1) PG8_BAR; }
    }
    PG8_WAIT_V(0);
    if constexpr (!ALIGN_EPI) { if (wr == 0) PG8_BAR; }
    PG8_BAR;
    if constexpr (Epi::AFTER_DRAIN) { E.fused(acc, cur, wr, wc, fr, fq, lds, wid, lane); S.done(cur); }
#undef PG8_SA
#undef PG8_SB
#undef PG8_STAGE
#undef PG8_LDA
#undef PG8_LDB
#undef PG8_MMA
#undef PG8_WAIT_V
#undef PG8_WAIT_L
#undef PG8_BAR
#undef PG8_SCHED
}
}

constexpr int NWAVES = 8, NTHR = NWAVES * 64;
constexpr int SEQ = 16384, DM = 2048, HD = 128, AH = 8, BH = 8, IH = 16, ID = 64, NIN = 9296;
constexpr int NPROJ = 5376;
constexpr int NWROWS = NPROJ;
constexpr int N8 = 4096;
constexpr float EPS = 1e-6f;
#ifndef MK_N_LAUNCHES
#define MK_N_LAUNCHES 1
#endif
constexpr int N_PHASES = 7;
#ifndef IXP_SCORE
#define IXP_SCORE 1
#endif
#ifndef IXP_TAIL
#define IXP_TAIL 1
#endif
#ifndef IXP_ATOM2
#define IXP_ATOM2 0
#endif
#ifndef REP_GEMM
#define REP_GEMM 1
#endif
#ifndef REP_IDX
#define REP_IDX 1
#endif
#ifndef REP_ATT
#define REP_ATT 1
#endif
#ifndef REP_HG
#define REP_HG 1
#endif
#ifndef REP_P0
#define REP_P0 1
#endif
#ifndef REP_OUT
#define REP_OUT 1
#endif
#ifndef REP_P01
#define REP_P01 1
#endif

constexpr size_t MiB = 1u << 20;
constexpr size_t WS_CTL = 0, CTL_ZERO_BYTES = 64 * 1024;
constexpr size_t WS_WIN = 1 * MiB;
constexpr size_t WS_WOUT = 39 * MiB;
constexpr size_t WS_H = 47 * MiB;
constexpr size_t WS_PROJ = 111 * MiB;
constexpr size_t PROJ_STRIDE = 32 * MiB;
constexpr size_t WS_TAIL = 367 * MiB;
constexpr size_t WS_VT = 375 * MiB;
constexpr size_t WS_MASK = 407 * MiB;
constexpr size_t WS_IKB = 439 * MiB;
constexpr size_t WS_GS = 441 * MiB;
constexpr size_t WS_GD = 457 * MiB;
constexpr size_t WS_KF = 391 * MiB;
constexpr size_t WS_H8 = 458 * MiB;
constexpr size_t WS_STAT = 490 * MiB;
constexpr size_t WS_W8 = 491 * MiB;
constexpr size_t WS_END = 499 * MiB;
enum { PB_Q = 0, PB_K = 1, PB_AG = 2, PB_QI = 3, PB_RQ = 4, PB_RF = 5, PB_RI = 6, PB_RG = 7 };

constexpr int LDS_BYTES = 157696;
constexpr int LDS_BARST = LDS_BYTES - 64;
constexpr size_t CTL_BAR_OFF = 32768;

#define LAS __attribute__((address_space(3)))
typedef unsigned short bf16;
typedef unsigned v4u __attribute__((ext_vector_type(4)));
typedef unsigned v2u __attribute__((ext_vector_type(2)));
typedef float f32x4 __attribute__((ext_vector_type(4)));
typedef float f32x16 __attribute__((ext_vector_type(16)));
typedef short bf16x8 __attribute__((ext_vector_type(8)));

__device__ __forceinline__ unsigned f2bf(float f) { unsigned u = __builtin_bit_cast(unsigned, f); return (u + 0x7fffu + ((u >> 16) & 1u)) >> 16; }
typedef float f32x2_t __attribute__((ext_vector_type(2))); typedef __bf16 bf16x2_t __attribute__((ext_vector_type(2)));
__device__ __forceinline__ unsigned pk2(float lo, float hi) { f32x2_t v = {lo, hi}; bf16x2_t b = __builtin_convertvector(v, bf16x2_t); return __builtin_bit_cast(unsigned, b); }
__device__ __forceinline__ float bflo(unsigned w) { return __builtin_bit_cast(float, w << 16); }
__device__ __forceinline__ float bfhi(unsigned w) { return __builtin_bit_cast(float, w & 0xffff0000u); }
__device__ __forceinline__ float wave_sum(float v) {
#pragma unroll
    for (int o = 1; o < 64; o <<= 1) v += __shfl_xor(v, o);
    return v;
}
__device__ __forceinline__ float relu1(float x) { const int xi = __builtin_bit_cast(int, x); return __builtin_bit_cast(float, xi > 0 ? xi : 0); }
__device__ __forceinline__ float sigmoidf_(float x) { return __builtin_amdgcn_rcpf(1.0f + __expf(-x)); }
__device__ __forceinline__ float siluf_(float x) { return x * __builtin_amdgcn_rcpf(1.0f + __expf(-x)); }
__device__ __forceinline__ void unpack8(const v4u w, float (&f)[8]) {
    f[0] = bflo(w.x); f[1] = bfhi(w.x); f[2] = bflo(w.y); f[3] = bfhi(w.y); f[4] = bflo(w.z); f[5] = bfhi(w.z); f[6] = bflo(w.w); f[7] = bfhi(w.w);
}
__device__ __forceinline__ v4u pack8(const float (&f)[8]) { v4u w; w.x = pk2(f[0], f[1]); w.y = pk2(f[2], f[3]); w.z = pk2(f[4], f[5]); w.w = pk2(f[6], f[7]); return w; }

struct Args {
    const float* x; const float* c; const int* pos; const float* ada_w; const float* ada_b; const float* norm_g; const float* w_in;
    const float* q_norm_g; const float* k_norm_g; const float* ik_norm_g; const float* lb_logits; const float* hgrn_norm_g; const float* w_out;
    float* out; unsigned char* ws;
    float invf_a[64]; float invf_i[32];
    int ph_lo, ph_hi, bar_region, pad0;
};

__device__ __forceinline__ void transpose_item(const float* W, int N, int K, int ocol0, int nvalid, bf16* WT, int drow0, LAS float* scr, int k0, int lane) {
#pragma unroll 8
    for (int i = 0; i < 32; ++i) { const int kk = 2 * i + (lane >> 5), cc = lane & 31;
        scr[kk * 33 + cc] = (cc < nvalid) ? W[(size_t)(k0 + kk) * N + ocol0 + cc] : 0.f; }
    asm volatile("s_waitcnt lgkmcnt(0)" ::: "memory");
    const int c = lane & 7;
#pragma unroll
    for (int j = 0; j < 4; ++j) { const int n = (lane >> 3) + 8 * j; const LAS float* s = scr + (8 * c) * 33 + n;
        v4u o; o.x = pk2(s[0 * 33], s[1 * 33]); o.y = pk2(s[2 * 33], s[3 * 33]); o.z = pk2(s[4 * 33], s[5 * 33]); o.w = pk2(s[6 * 33], s[7 * 33]);
        *(v4u*)(WT + (size_t)(drow0 + n) * K + k0 + 8 * c) = o; }
    asm volatile("s_waitcnt lgkmcnt(0)" ::: "memory");
}
__device__ __forceinline__ void phase0(const Args& a, LAS unsigned char* lds, int tid, int wave, int lane, bool do_gemv) {
    bf16* WIN = (bf16*)(a.ws + WS_WIN); bf16* WOUT = (bf16*)(a.ws + WS_WOUT);
    LAS float* scr = (LAS float*)(lds + wave * 8704);
    const int gw = blockIdx.x * NWAVES + wave, NGW = gridDim.x * NWAVES;
    constexpr int I_IN = (NWROWS / 32) * (DM / 64), I_OUT = (DM / 32) * (DM / 64), I_8 = (N8 / 32) * (DM / 64);
    unsigned char* W8 = (unsigned char*)(a.ws + WS_W8);
    auto decode = [&](int it, const float*& src, int& N, int& nv, int& kind, int& drow0, int& k0) {
        if (it < I_IN) { const int nb = it % (NWROWS / 32), kb = it / (NWROWS / 32); const int d0 = nb * 32; int o; nv = 32;
            if (d0 < 1024) o = 4096 + d0; else if (d0 < 5120) o = 5200 + (d0 - 1024);
            else { const int rel = d0 - 5120; o = 5120 + rel; nv = 80 - rel; nv = nv < 0 ? 0 : (nv > 32 ? 32 : nv); if (nv == 0) o = 0; }
            kind = 0; N = NIN; drow0 = d0; k0 = kb * 64; src = a.w_in + (size_t)k0 * NIN + o;
        } else if (it < I_IN + I_OUT) { const int r = it - I_IN; const int nb = r % (DM / 32), kb = r / (DM / 32);
            kind = 1; N = DM; nv = 32; drow0 = nb * 32; k0 = kb * 64; src = a.w_out + (size_t)k0 * DM + nb * 32;
        } else { const int r = it - I_IN - I_OUT; const int nb = r % (N8 / 32), kb = r / (N8 / 32);
            kind = 2; N = NIN; nv = 32; drow0 = nb * 32; k0 = kb * 64; src = a.w_in + (size_t)k0 * NIN + nb * 32; }
    };
    const int ITOT = I_IN + I_OUT + I_8;
    float cur[32], nxv[32];
    const float* csrc = nullptr; int cN = 0, cnv = 0, ckind = 0, cdrow = 0, ck0 = 0;
    if (gw < ITOT) { decode(gw, csrc, cN, cnv, ckind, cdrow, ck0);
#pragma unroll
        for (int i = 0; i < 32; ++i) cur[i] = ((lane & 31) < cnv) ? csrc[(size_t)(2 * i + (lane >> 5)) * cN + (lane & 31)] : 0.f; }
    for (int it = gw; it < ITOT; it += NGW) {
        const float* nsrc = nullptr; int nN = 0, nnv = 0, nkind = 0, ndrow = 0, nk0 = 0;
        if (it + NGW < ITOT) { decode(it + NGW, nsrc, nN, nnv, nkind, ndrow, nk0);
#pragma unroll
            for (int i = 0; i < 32; ++i) nxv[i] = ((lane & 31) < nnv) ? nsrc[(size_t)(2 * i + (lane >> 5)) * nN + (lane & 31)] : 0.f; }
#pragma unroll
        for (int i = 0; i < 32; ++i) scr[(2 * i + (lane >> 5)) * 33 + (lane & 31)] = cur[i];
        asm volatile("s_waitcnt lgkmcnt(0)" ::: "memory");
        if (ckind < 2) { bf16* WT = ckind ? WOUT : WIN; const int c = lane & 7;
#pragma unroll
            for (int j = 0; j < 4; ++j) { const int n = (lane >> 3) + 8 * j; const LAS float* sq = scr + (8 * c) * 33 + n;
                v4u o; o.x = pk2(sq[0 * 33], sq[1 * 33]); o.y = pk2(sq[2 * 33], sq[3 * 33]); o.z = pk2(sq[4 * 33], sq[5 * 33]); o.w = pk2(sq[6 * 33], sq[7 * 33]);
                *(v4u*)(WT + (size_t)(cdrow + n) * DM + ck0 + 8 * c) = o; }
        } else { const int n = lane >> 1, hf = lane & 1; const LAS float* sp = scr + (32 * hf) * 33 + n; v4u w0, w1; int t_;
#define W8PK(D, I) t_ = __builtin_amdgcn_cvt_pk_fp8_f32(sp[(I) * 33] * 32.f, sp[((I) + 1) * 33] * 32.f, 0, false); t_ = __builtin_amdgcn_cvt_pk_fp8_f32(sp[((I) + 2) * 33] * 32.f, sp[((I) + 3) * 33] * 32.f, t_, true); D = (unsigned)t_
            W8PK(w0.x, 0); W8PK(w0.y, 4); W8PK(w0.z, 8); W8PK(w0.w, 12); W8PK(w1.x, 16); W8PK(w1.y, 20); W8PK(w1.z, 24); W8PK(w1.w, 28);
#undef W8PK
            unsigned char* dst = W8 + (size_t)(cdrow + n) * DM + ck0 + 32 * hf;
            *(v4u*)dst = w0; *(v4u*)(dst + 16) = w1; }
        asm volatile("s_waitcnt lgkmcnt(0)" ::: "memory");
#pragma unroll
        for (int i = 0; i < 32; ++i) cur[i] = nxv[i];
        csrc = nsrc; cN = nN; cnv = nnv; ckind = nkind; cdrow = ndrow; ck0 = nk0;
    }
    float* mod = (float*)(a.ws + WS_CTL);
    if (do_gemv) for (int kb = blockIdx.x; kb < DM / 8; kb += gridDim.x) {
        f32x4 acc[3];
#pragma unroll
        for (int j = 0; j < 3; ++j) acc[j] = (f32x4){0.f, 0.f, 0.f, 0.f};
#pragma unroll
        for (int r = 0; r < 8; ++r) { const float s = siluf_(a.c[kb * 8 + r]); const f32x4* wr = (const f32x4*)(a.ada_w + (size_t)(kb * 8 + r) * (3 * DM));
#pragma unroll
            for (int j = 0; j < 3; ++j) acc[j] += s * wr[tid + 512 * j]; }
#pragma unroll
        for (int j = 0; j < 3; ++j) { const int c0 = 4 * (tid + 512 * j);
            if (kb == 0) acc[j] += *(const f32x4*)(a.ada_b + c0);
            atomicAdd(mod + c0 + 0, acc[j][0]); atomicAdd(mod + c0 + 1, acc[j][1]); atomicAdd(mod + c0 + 2, acc[j][2]); atomicAdd(mod + c0 + 3, acc[j][3]); }
    }
}

__device__ __forceinline__ void phase1(const Args& a, int wave, int lane) {
    const float* mod = (const float*)(a.ws + WS_CTL); bf16* H = (bf16*)(a.ws + WS_H);
    const int gw = blockIdx.x * NWAVES + wave, NGW = gridDim.x * NWAVES;
    if (gw >= SEQ) return;
    f32x4 fa[8], fb[8];
#pragma unroll
    for (int j = 0; j < 8; ++j) { const int c0 = 4 * lane + 256 * j;
        const f32x4 g = *(const f32x4*)(a.norm_g + c0), sh = *(const f32x4*)(mod + c0), sc = *(const f32x4*)(mod + DM + c0);
        fa[j] = g * (sc + 1.0f); fb[j] = sh; }
    f32x4 v[8], nx[8];
    { const f32x4* xr = (const f32x4*)(a.x + (size_t)gw * DM) + lane;
#pragma unroll
      for (int j = 0; j < 8; ++j) v[j] = xr[64 * j]; }
    for (int m = gw; m < SEQ; m += NGW) {
        if (m + NGW < SEQ) { const f32x4* xn = (const f32x4*)(a.x + (size_t)(m + NGW) * DM) + lane;
#pragma unroll
            for (int j = 0; j < 8; ++j) nx[j] = xn[64 * j]; }
        float s = 0.f;
#pragma unroll
        for (int j = 0; j < 8; ++j) s += (v[j][0] * v[j][0] + v[j][1] * v[j][1]) + (v[j][2] * v[j][2] + v[j][3] * v[j][3]);
        const float rstd = rsqrtf(wave_sum(s) * (1.f / DM) + EPS);
        v2u* o8 = (v2u*)(H + (size_t)m * DM) + lane; unsigned* h8 = (unsigned*)(a.ws + WS_H8 + (size_t)m * DM) + lane;
#pragma unroll
        for (int j = 0; j < 8; ++j) {
            const f32x4 y = (v[j] * rstd) * fa[j] + fb[j];
            v2u w; w.x = pk2(y[0], y[1]); w.y = pk2(y[2], y[3]); o8[64 * j] = w;
            int t_ = __builtin_amdgcn_cvt_pk_fp8_f32(y[0], y[1], 0, false); t_ = __builtin_amdgcn_cvt_pk_fp8_f32(y[2], y[3], t_, true); h8[64 * j] = (unsigned)t_; }
#pragma unroll
        for (int j = 0; j < 8; ++j) v[j] = nx[j];
    }
}

__device__ __forceinline__ void rope_cs(float posf, const float* invf, int d0, float (&cs)[8], float (&sn)[8]) {
#pragma unroll
    for (int e = 0; e < 8; ++e) { const float ang = posf * invf[d0 + e];
        double fr = (double)ang * 0.15915494309189535; fr = fr - __builtin_rint(fr); const float f = (float)fr;
        cs[e] = __builtin_amdgcn_cosf(f); sn[e] = __builtin_amdgcn_sinf(f); }
}
__device__ __forceinline__ void phase3_post(const Args& a, int wave, int lane) {
    bf16* Q = (bf16*)(a.ws + WS_PROJ + PB_Q * PROJ_STRIDE); bf16* K = (bf16*)(a.ws + WS_PROJ + PB_K * PROJ_STRIDE); bf16* QI = (bf16*)(a.ws + WS_PROJ + PB_QI * PROJ_STRIDE);
    const float* TAIL = (const float*)(a.ws + WS_TAIL); bf16* IKB = (bf16*)(a.ws + WS_IKB); bf16* KF = (bf16*)(a.ws + WS_KF); float* STAT = (float*)(a.ws + WS_STAT);
    const int gw = blockIdx.x * NWAVES + wave, NGW = gridDim.x * NWAVES;
    for (int m = gw; m < SEQ; m += NGW) {
        const float posf = (float)a.pos[m];
        {
            const int hd = lane >> 3, j = lane & 7; float cs[8], sn[8]; rope_cs(posf, a.invf_a, 8 * j, cs, sn);
            constexpr float C2 = 0.71419166f;
#pragma unroll
            for (int which = 0; which < 2; ++which) {
                bf16* base = (which ? K : Q) + (size_t)m * 1024 + hd * 128 + 8 * j; const float* g = which ? a.k_norm_g : a.q_norm_g;
                float xa[8], xb[8]; unpack8(*(const v4u*)base, xa); unpack8(*(const v4u*)(base + 64), xb);
                float ss = 0.f;
#pragma unroll
                for (int e = 0; e < 8; ++e) ss += xa[e] * xa[e] + xb[e] * xb[e];
                ss += __shfl_xor(ss, 1); ss += __shfl_xor(ss, 2); ss += __shfl_xor(ss, 4);
                const float rstd = rsqrtf(ss * (1.f / 128.f) + EPS) * C2;
                float oa[8], ob[8];
#pragma unroll
                for (int e = 0; e < 8; ++e) { const float ya = xa[e] * rstd * g[8 * j + e], yb = xb[e] * rstd * g[64 + 8 * j + e];
                    oa[e] = ya * cs[e] - yb * sn[e]; ob[e] = yb * cs[e] + ya * sn[e]; }
                if (which == 0) { *(v4u*)base = pack8(oa); *(v4u*)(base + 64) = pack8(ob); }
                else {
                    const int kk = m & 31, r = (kk & 0x13) | ((kk & 4) << 1) | ((kk & 8) >> 1);
                    unsigned char* tb = (unsigned char*)KF + (size_t)(hd * 512 + (m >> 5)) * 4096 + (size_t)((j >> 1) & 1) * 1024 + ((j >> 2) * 32 + r) * 16 + 8 * (j & 1);
                    v2u wa, wb; int t_;
                    t_ = __builtin_amdgcn_cvt_pk_fp8_f32(oa[0], oa[1], 0, false); t_ = __builtin_amdgcn_cvt_pk_fp8_f32(oa[2], oa[3], t_, true); wa.x = (unsigned)t_;
                    t_ = __builtin_amdgcn_cvt_pk_fp8_f32(oa[4], oa[5], 0, false); t_ = __builtin_amdgcn_cvt_pk_fp8_f32(oa[6], oa[7], t_, true); wa.y = (unsigned)t_;
                    t_ = __builtin_amdgcn_cvt_pk_fp8_f32(ob[0], ob[1], 0, false); t_ = __builtin_amdgcn_cvt_pk_fp8_f32(ob[2], ob[3], t_, true); wb.x = (unsigned)t_;
                    t_ = __builtin_amdgcn_cvt_pk_fp8_f32(ob[4], ob[5], 0, false); t_ = __builtin_amdgcn_cvt_pk_fp8_f32(ob[6], ob[7], t_, true); wb.y = (unsigned)t_;
                    *(v2u*)tb = wa; *(v2u*)(tb + 2048) = wb;
                }
            }
        }
        {
            const int hd = lane >> 2, j = lane & 3; float cs[8], sn[8]; rope_cs(posf, a.invf_i, 8 * j, cs, sn);
            bf16* base = QI + (size_t)m * 1024 + hd * 64 + 8 * j;
            float xa[8], xb[8]; unpack8(*(const v4u*)base, xa); unpack8(*(const v4u*)(base + 32), xb);
            float oa[8], ob[8];
#pragma unroll
            for (int e = 0; e < 8; ++e) { oa[e] = xa[e] * cs[e] - xb[e] * sn[e]; ob[e] = xb[e] * cs[e] + xa[e] * sn[e]; }
            *(v4u*)base = pack8(oa); *(v4u*)(base + 32) = pack8(ob);
            {
                float sq = 0.f;
#pragma unroll
                for (int e = 0; e < 8; ++e) sq += xa[e] * xa[e] + xb[e] * xb[e];
                sq += __shfl_xor(sq, 1); sq += __shfl_xor(sq, 2);
                const float wh = TAIL[(size_t)m * 128 + 64 + hd] * 0.25f, sg = 0.125f * sqrtf(sq);
                const float mu = 0.25f * wave_sum(wh * sg * 0.39894228f), var = 0.25f * wave_sum(wh * wh * sg * sg * 0.34084f);
                if (lane == 0) { STAT[2 * m] = mu; STAT[2 * m + 1] = 24.0f * rsqrtf(fmaxf(var, 1e-20f)); }
            }
            const float* tr = TAIL + (size_t)m * 128;
            const f32x4 a0 = *(const f32x4*)(tr + 8 * j), a1 = *(const f32x4*)(tr + 8 * j + 4), b0 = *(const f32x4*)(tr + 32 + 8 * j), b1 = *(const f32x4*)(tr + 32 + 8 * j + 4);
            float ka[8] = {a0[0], a0[1], a0[2], a0[3], a1[0], a1[1], a1[2], a1[3]}, kb[8] = {b0[0], b0[1], b0[2], b0[3], b1[0], b1[1], b1[2], b1[3]};
            float ss = 0.f;
#pragma unroll
            for (int e = 0; e < 8; ++e) ss += ka[e] * ka[e] + kb[e] * kb[e];
            ss += __shfl_xor(ss, 1); ss += __shfl_xor(ss, 2);
            const float rstd = rsqrtf(ss * (1.f / 64.f) + EPS);
#pragma unroll
            for (int e = 0; e < 8; ++e) { const float ya = ka[e] * rstd * a.ik_norm_g[8 * j + e], yb = kb[e] * rstd * a.ik_norm_g[32 + 8 * j + e];
                oa[e] = ya * cs[e] - yb * sn[e]; ob[e] = yb * cs[e] + ya * sn[e]; }
            if (lane < 4) {
                const size_t g = (size_t)(m >> 5), c = (size_t)(m & 31); const int s0 = j >> 1, h = j & 1;
                *(v4u*)(IKB + (((g * 4 + s0) * 64) + h * 32 + c) * 8) = pack8(oa);
                *(v4u*)(IKB + (((g * 4 + 2 + s0) * 64) + h * 32 + c) * 8) = pack8(ob);
            }
        }
    }
}

constexpr int HG_TOK = 512, HG_NG = SEQ / HG_TOK;
constexpr int HL_B = 0, HL_K1 = 32768, HL_QD = 49152, HL_KD = 66560, HL_QB = 83968, HL_KLT = 101376, HL_IT = 119808, HL_A = 138240, HL_DEC = 147456, HL_END = 147968;
static_assert(HL_END + 512 <= LDS_BYTES, "hgrn LDS");
typedef float f32x4h __attribute__((ext_vector_type(4)));
template <bool OUTPUT>
__device__ __forceinline__ void hgrn_unit(const Args& a, LAS unsigned char* lds, int hd, int g, int tid, int wave, int lane) {
    const bf16* RQ = (const bf16*)(a.ws + WS_PROJ + PB_RQ * PROJ_STRIDE); const bf16* RF = (const bf16*)(a.ws + WS_PROJ + PB_RF * PROJ_STRIDE);
    const bf16* RI = (const bf16*)(a.ws + WS_PROJ + PB_RI * PROJ_STRIDE); const bf16* RG = (const bf16*)(a.ws + WS_PROJ + PB_RG * PROJ_STRIDE);
    float* GS = (float*)(a.ws + WS_GS); float* GD = (float*)(a.ws + WS_GD); bf16* MIX = (bf16*)(a.ws + WS_H);
    LAS float* Bf = (LAS float*)(lds + HL_B); LAS unsigned short* K1 = (LAS unsigned short*)(lds + HL_K1); LAS float* decs = (LAS float*)(lds + HL_DEC);
    LAS float* tot = (LAS float*)(lds + HL_A);
    const int fr = lane & 15, fg = lane >> 4;
    const int c8 = tid & 15;
    LAS float* lbv = (LAS float*)(lds + HL_END);
    if (tid < 128) { const int col = hd * 128 + tid; lbv[tid] = __builtin_amdgcn_rcpf(1.0f + __expf(a.lb_logits[1024 + col] - a.lb_logits[col])); }
    __syncthreads();
    f32x4h Sacc[8];
    const size_t sbase = ((size_t)(hd * HG_NG + g) * 128) * 128;
    const int ecol = 16 * wave + fr;
#pragma unroll
    for (int dt = 0; dt < 8; ++dt)
#pragma unroll
        for (int rg = 0; rg < 4; ++rg) Sacc[dt][rg] = OUTPUT ? GS[sbase + (size_t)(16 * dt + 4 * fg + rg) * 128 + ecol] : 0.f;
    float gdl = 0.f;
    const int tok0 = g * HG_TOK;
    v4u pfF[2], pfI[2], pfQ[2];
#pragma unroll
    for (int rep2 = 0; rep2 < 2; ++rep2) { const size_t off = (size_t)(tok0 + (tid >> 4) + 32 * rep2) * 1024 + hd * 128 + 8 * c8;
        pfF[rep2] = *(const v4u*)(RF + off); pfI[rep2] = *(const v4u*)(RI + off); if (OUTPUT) pfQ[rep2] = *(const v4u*)(RQ + off); }
    for (int ch = 0; ch < HG_TOK / 64; ++ch) {
        const int t0 = tok0 + 64 * ch;
        const int tnx = tok0 + 64 * (ch + 1 < HG_TOK / 64 ? ch + 1 : ch);
#pragma unroll
        for (int rep2 = 0; rep2 < 2; ++rep2) { const int s = (tid >> 4) + 32 * rep2;
            float f[8]; unpack8(pfF[rep2], f); float kk[8];
            const f32x4 l0 = *(const LAS f32x4*)(lbv + 8 * c8), l1 = *(const LAS f32x4*)(lbv + 8 * c8 + 4);
            const float lb8[8] = {l0[0], l0[1], l0[2], l0[3], l1[0], l1[1], l1[2], l1[3]};
#pragma unroll
            for (int e = 0; e < 8; ++e) { const float fv = lb8[e] + (1.0f - lb8[e]) * sigmoidf_(f[e]); kk[e] = 1.0f - fv; f[e] = __logf(fv); }
            *(LAS f32x4*)(Bf + s * 128 + 8 * c8) = (f32x4){f[0], f[1], f[2], f[3]}; *(LAS f32x4*)(Bf + s * 128 + 8 * c8 + 4) = (f32x4){f[4], f[5], f[6], f[7]};
            *(LAS v4u*)(K1 + s * 128 + 8 * c8) = pack8(kk);
            const v4u iv = pfI[rep2];
            LAS unsigned short* itp = (LAS unsigned short*)(lds + HL_IT) + (8 * c8) * 72 + s;
            itp[0 * 72] = (unsigned short)(iv.x & 0xffffu); itp[1 * 72] = (unsigned short)(iv.x >> 16); itp[2 * 72] = (unsigned short)(iv.y & 0xffffu); itp[3 * 72] = (unsigned short)(iv.y >> 16);
            itp[4 * 72] = (unsigned short)(iv.z & 0xffffu); itp[5 * 72] = (unsigned short)(iv.z >> 16); itp[6 * 72] = (unsigned short)(iv.w & 0xffffu); itp[7 * 72] = (unsigned short)(iv.w >> 16); }
#pragma unroll
        for (int rep2 = 0; rep2 < 2; ++rep2) { const size_t offn = (size_t)(tnx + (tid >> 4) + 32 * rep2) * 1024 + hd * 128 + 8 * c8;
            pfF[rep2] = *(const v4u*)(RF + offn); pfI[rep2] = *(const v4u*)(RI + offn); }
        __syncthreads();
        { const int d = tid & 127, qq = tid >> 7; float cv[16];
#pragma unroll
            for (int k = 0; k < 16; ++k) cv[k] = Bf[(16 * qq + k) * 128 + d];
#pragma unroll
            for (int k = 1; k < 16; ++k) cv[k] += cv[k - 1];
            tot[qq * 128 + d] = cv[15];
            __syncthreads();
            float offv = 0.f;
#pragma unroll
            for (int q2 = 0; q2 < 3; ++q2) offv += (q2 < qq) ? tot[q2 * 128 + d] : 0.f;
#pragma unroll
            for (int k = 0; k < 16; ++k) Bf[(16 * qq + k) * 128 + d] = cv[k] + offv;
            if (qq == 3) { const float bl = cv[15] + offv; decs[d] = __expf(bl); if (!OUTPUT) gdl += bl; }
        }
        __syncthreads();
        if (OUTPUT) {
#pragma unroll
            for (int rep2 = 0; rep2 < 2; ++rep2) { const int s = (tid >> 4) + 32 * rep2;
                float q[8]; unpack8(pfQ[rep2], q); float kk[8]; unpack8(*(const LAS v4u*)(K1 + s * 128 + 8 * c8), kk);
                const f32x4 b0 = *(const LAS f32x4*)(Bf + s * 128 + 8 * c8), b1 = *(const LAS f32x4*)(Bf + s * 128 + 8 * c8 + 4);
                const f32x4 m0 = *(const LAS f32x4*)(Bf + 31 * 128 + 8 * c8), m1 = *(const LAS f32x4*)(Bf + 31 * 128 + 8 * c8 + 4);
                const float bv[8] = {b0[0], b0[1], b0[2], b0[3], b1[0], b1[1], b1[2], b1[3]}, mv[8] = {m0[0], m0[1], m0[2], m0[3], m1[0], m1[1], m1[2], m1[3]};
                float qd[8], kd[8], qb[8];
#pragma unroll
                for (int e = 0; e < 8; ++e) { const float qs = siluf_(q[e]); qb[e] = qs * __expf(bv[e]); qd[e] = qs * __expf(bv[e] - mv[e]); kd[e] = kk[e] * __expf(mv[e] - bv[e]); }
                *(LAS v4u*)(lds + HL_QD + (s * 136 + 8 * c8) * 2) = pack8(qd); *(LAS v4u*)(lds + HL_KD + (s * 136 + 8 * c8) * 2) = pack8(kd); *(LAS v4u*)(lds + HL_QB + (s * 136 + 8 * c8) * 2) = pack8(qb); }
#pragma unroll
            for (int rep2 = 0; rep2 < 2; ++rep2) pfQ[rep2] = *(const v4u*)(RQ + (size_t)(tnx + (tid >> 4) + 32 * rep2) * 1024 + hd * 128 + 8 * c8);
        }
#pragma unroll
        for (int rep2 = 0; rep2 < 2; ++rep2) { const int it = tid + 512 * rep2; const int d = it & 127, s0 = 8 * (it >> 7); const float bl = Bf[63 * 128 + d]; float kl[8];
#pragma unroll
            for (int jx = 0; jx < 8; ++jx) { const float kv = bflo((unsigned)K1[(s0 + jx) * 128 + d]); kl[jx] = kv * __expf(bl - Bf[(s0 + jx) * 128 + d]); }
            *(LAS v4u*)(lds + HL_KLT + (d * 72 + s0) * 2) = pack8(kl); }
        __syncthreads();
        f32x4h oacc[4];
        unsigned gpre[8];
        if (OUTPUT) {
#pragma unroll
            for (int i2 = 0; i2 < 8; ++i2) gpre[i2] = *(const unsigned*)(RG + (size_t)(t0 + 8 * wave + i2) * 1024 + hd * 128 + 2 * lane);
#pragma unroll
            for (int k2 = 0; k2 < 2; ++k2) { const int tl = 2 * wave + k2, st = tl >> 2, ct = tl & 3;
                f32x4h acc = {0.f, 0.f, 0.f, 0.f};
                if (st <= ct) {
#pragma unroll
                    for (int ks = 0; ks < 4; ++ks) { const bf16x8 A = *(const LAS bf16x8*)(lds + HL_KD + ((16 * st + fr) * 136 + 32 * ks + 8 * fg) * 2);
                        const bf16x8 B = *(const LAS bf16x8*)(lds + HL_QD + ((16 * ct + fr) * 136 + 32 * ks + 8 * fg) * 2);
                        acc = __builtin_amdgcn_mfma_f32_16x16x32_bf16(A, B, acc, 0, 0, 0); } }
                const int cidx = 16 * ct + fr, sidx = 16 * st + 4 * fg;
                v2u w; w.x = pk2(sidx + 0 <= cidx ? acc[0] : 0.f, sidx + 1 <= cidx ? acc[1] : 0.f); w.y = pk2(sidx + 2 <= cidx ? acc[2] : 0.f, sidx + 3 <= cidx ? acc[3] : 0.f);
                *(LAS v2u*)(lds + HL_A + (cidx * 72 + sidx) * 2) = w; }
            __syncthreads();
#pragma unroll
            for (int ct = 0; ct < 4; ++ct) { oacc[ct] = (f32x4h){0.f, 0.f, 0.f, 0.f};
#pragma unroll
                for (int ks = 0; ks < 2; ++ks) if (ks == 0 || ct >= 2) { const bf16x8 A = *(const LAS bf16x8*)(lds + HL_A + ((16 * ct + fr) * 72 + 32 * ks + 8 * fg) * 2);
                    const bf16x8 B = *(const LAS bf16x8*)(lds + HL_IT + ((16 * wave + fr) * 72 + 32 * ks + 8 * fg) * 2);
                    oacc[ct] = __builtin_amdgcn_mfma_f32_16x16x32_bf16(A, B, oacc[ct], 0, 0, 0); } }
#pragma unroll
            for (int k4 = 0; k4 < 4; ++k4) { v4u sw; sw.x = pk2(Sacc[2 * k4][0], Sacc[2 * k4][1]); sw.y = pk2(Sacc[2 * k4][2], Sacc[2 * k4][3]); sw.z = pk2(Sacc[2 * k4 + 1][0], Sacc[2 * k4 + 1][1]); sw.w = pk2(Sacc[2 * k4 + 1][2], Sacc[2 * k4 + 1][3]);
                const bf16x8 Sb = __builtin_bit_cast(bf16x8, sw);
#pragma unroll
                for (int ct = 0; ct < 4; ++ct) { const v2u lo = *(const LAS v2u*)(lds + HL_QB + ((16 * ct + fr) * 136 + 32 * k4 + 4 * fg) * 2), hi2 = *(const LAS v2u*)(lds + HL_QB + ((16 * ct + fr) * 136 + 32 * k4 + 16 + 4 * fg) * 2);
                    v4u aw; aw.x = lo.x; aw.y = lo.y; aw.z = hi2.x; aw.w = hi2.y;
                    oacc[ct] = __builtin_amdgcn_mfma_f32_16x16x32_bf16(__builtin_bit_cast(bf16x8, aw), Sb, oacc[ct], 0, 0, 0); } }
        }
#pragma unroll
        for (int dt = 0; dt < 8; ++dt) { const f32x4 dc = *(const LAS f32x4*)(decs + 16 * dt + 4 * fg);
            Sacc[dt][0] *= dc[0]; Sacc[dt][1] *= dc[1]; Sacc[dt][2] *= dc[2]; Sacc[dt][3] *= dc[3];
#pragma unroll
            for (int ks = 0; ks < 2; ++ks) { const bf16x8 A = *(const LAS bf16x8*)(lds + HL_KLT + ((16 * dt + fr) * 72 + 32 * ks + 8 * fg) * 2);
                const bf16x8 B = *(const LAS bf16x8*)(lds + HL_IT + ((16 * wave + fr) * 72 + 32 * ks + 8 * fg) * 2);
                Sacc[dt] = __builtin_amdgcn_mfma_f32_16x16x32_bf16(A, B, Sacc[dt], 0, 0, 0); } }
        if (OUTPUT) {
#pragma unroll
            for (int ct = 0; ct < 4; ++ct)
#pragma unroll
                for (int rg = 0; rg < 4; ++rg) Bf[(16 * ct + 4 * fg + rg) * 128 + ecol] = oacc[ct][rg];
            __syncthreads();
#pragma unroll
            for (int i2 = 0; i2 < 8; ++i2) { const int c = 8 * wave + i2; const int m = t0 + c;
                const float o0 = Bf[c * 128 + 2 * lane], o1 = Bf[c * 128 + 2 * lane + 1];
                const float rstd = rsqrtf(wave_sum(o0 * o0 + o1 * o1) * (1.f / 128.f) + EPS);
                const unsigned gw2 = gpre[i2];
                const float y0 = o0 * rstd * a.hgrn_norm_g[2 * lane] * siluf_(bflo(gw2)), y1 = o1 * rstd * a.hgrn_norm_g[2 * lane + 1] * siluf_(bfhi(gw2));
                *(unsigned*)(MIX + (size_t)m * DM + 1024 + hd * 128 + 2 * lane) = pk2(y0, y1); }
        }
        __syncthreads();
    }
    if (!OUTPUT) {
#pragma unroll
        for (int dt = 0; dt < 8; ++dt)
#pragma unroll
            for (int rg = 0; rg < 4; ++rg) GS[sbase + (size_t)(16 * dt + 4 * fg + rg) * 128 + ecol] = Sacc[dt][rg];
        if (tid >= 384) GD[(size_t)(hd * HG_NG + g) * 128 + (tid & 127)] = __expf(gdl);
    }
}
__device__ __forceinline__ void hgrn_scan(const Args& a, int tid) {
    float* GS = (float*)(a.ws + WS_GS); const float* GD = (const float*)(a.ws + WS_GD);
    for (int id = blockIdx.x * NTHR + tid; id < BH * 128 * 128; id += gridDim.x * NTHR) {
        const int hd = id >> 14, d = (id >> 7) & 127, e = id & 127;
        float gs[HG_NG], gd[HG_NG];
#pragma unroll
        for (int g = 0; g < HG_NG; ++g) { gs[g] = GS[((size_t)(hd * HG_NG + g) * 128 + d) * 128 + e]; gd[g] = GD[(size_t)(hd * HG_NG + g) * 128 + d]; }
        float carry = 0.f;
#pragma unroll
        for (int g = 0; g < HG_NG; ++g) { GS[((size_t)(hd * HG_NG + g) * 128 + d) * 128 + e] = carry; carry = carry * gd[g] + gs[g]; }
    }
}

constexpr int IX_BINS = 0, IX_STG = 131072, IX_HIST = IX_STG + 16384, IX_CTL = IX_HIST + 8192, IX_CAP = 128;
static_assert(IX_CTL + 256 <= LDS_BYTES, "indexer LDS");
__device__ __forceinline__ void indexer_phase(const Args& a, LAS unsigned char* lds, int tid, int wave, int lane) {
    const bf16* QI = (const bf16*)(a.ws + WS_PROJ + PB_QI * PROJ_STRIDE); const bf16* IKB = (const bf16*)(a.ws + WS_IKB); const float* TAIL = (const float*)(a.ws + WS_TAIL);
    const float* STAT = (const float*)(a.ws + WS_STAT); unsigned* MASK = (unsigned*)(a.ws + WS_MASK);
    LAS unsigned char* bins = lds + IX_BINS; LAS unsigned* hist = (LAS unsigned*)(lds + IX_HIST); LAS unsigned short* ckeys = (LAS unsigned short*)(lds + IX_HIST);
    LAS float* cscore = (LAS float*)(lds + IX_HIST + 2048); LAS unsigned char* qst = lds + IX_STG; LAS int* ctl = (LAS int*)(lds + IX_CTL);
    const int G = gridDim.x, NU = SEQ / 8, rounds = (NU + G - 1) / G;
    const int r = lane & 31, h = lane >> 5;
    bf16x8 af[4][4]; float wv[4][16], mu[4], bsc[4]; int loaded = -1;
#define IX_LOADA(M0) do { const int qq_ = (r >> 2) & 1, head_ = (r & 3) + 4 * (r >> 3); \
        _Pragma("unroll") for (int p = 0; p < 4; ++p) { \
            _Pragma("unroll") for (int s = 0; s < 4; ++s) af[p][s] = *(const bf16x8*)(QI + (size_t)((M0) + 2 * p + qq_) * 1024 + head_ * 64 + 16 * s + 8 * h); \
            const float* wr_ = TAIL + (size_t)((M0) + 2 * p + h) * 128 + 64; \
            _Pragma("unroll") for (int t4 = 0; t4 < 4; ++t4) { const f32x4 w4 = *(const f32x4*)(wr_ + 4 * t4); wv[p][4 * t4] = w4[0]; wv[p][4 * t4 + 1] = w4[1]; wv[p][4 * t4 + 2] = w4[2]; wv[p][4 * t4 + 3] = w4[3]; } \
            mu[p] = STAT[2 * ((M0) + 2 * p + h)]; bsc[p] = STAT[2 * ((M0) + 2 * p + h) + 1]; } } while (0)
    for (int j = 0; j < rounds; ++j) {
        const int bx = __builtin_amdgcn_readfirstlane((int)blockIdx.x);
        const int u = (j & 1) ? (j * G + (G - 1 - bx)) : (j * G + bx);
        if (u >= NU) continue;
        const int m0 = 8 * u, L = 64 * ((m0 >> 6) + 1);
        if (L <= 256) {
            for (int w = tid; w < 4096; w += NTHR) { const int ww = w & 511; MASK[(size_t)(m0 + (w >> 9)) * 512 + ww] = (ww < (L >> 5)) ? 0xffffffffu : 0u; }
            continue;
        }
        const v4u qs0 = ((const v4u*)(QI + (size_t)(m0 + wave) * 1024))[lane], qs1 = ((const v4u*)(QI + (size_t)(m0 + wave) * 1024))[64 + lane];
        if (loaded != u) { IX_LOADA(m0); loaded = u; }
        for (int w = tid; w < 2048; w += NTHR) hist[w] = 0u;
        if (tid < 24) ctl[tid] = 0;
        __syncthreads();
        for (int rp = 0; rp < IXP_SCORE; ++rp) {
            if (rp > 0) { __syncthreads(); for (int w = tid; w < 2048; w += NTHR) hist[w] = 0u; __syncthreads(); }
            if (rp == 0) {
#pragma unroll
                for (int p = 0; p < 4; ++p) { mu[p] = 128.f - mu[p] * bsc[p]; bsc[p] *= 0.03125f; } }
            if (rp == 0) { *(LAS v4u*)(qst + wave * 2048 + lane * 16) = qs0; *(LAS v4u*)(qst + wave * 2048 + 1024 + lane * 16) = qs1; }
            const int ng = L >> 5;
            const bf16x8* bp = (const bf16x8*)IKB + lane;
#define IX_LOADB(B, GG) do { const int gk = ((GG) < ng) ? (GG) : ng - 1; _Pragma("unroll") for (int s = 0; s < 4; ++s) B[s] = bp[(size_t)gk * 256 + s * 64]; } while (0)
#define IX_VALU_(ACC, P) do { float s0 = 0.f, s1 = 0.f, s2 = 0.f, s3 = 0.f; \
                    _Pragma("unroll") for (int t = 0; t < 4; ++t) { s0 = fmaf(relu1(ACC[4 * t]), wv[P][4 * t], s0); s1 = fmaf(relu1(ACC[4 * t + 1]), wv[P][4 * t + 1], s1); \
                        s2 = fmaf(relu1(ACC[4 * t + 2]), wv[P][4 * t + 2], s2); s3 = fmaf(relu1(ACC[4 * t + 3]), wv[P][4 * t + 3], s3); } \
                    const float sv = (s0 + s1) + (s2 + s3); \
                    int b; asm("v_cvt_flr_i32_f32_e32 %0, %1" : "=v"(b) : "v"(fmaf(sv, bsc[P], mu[P]))); b = b < 0 ? 0 : (b > 255 ? 255 : b); \
                    bins[boff + 2 * (P) + h] = (unsigned char)b; \
                    __hip_atomic_fetch_add(&hist[(2 * (P) + h) * 256 + b], 1u, __ATOMIC_RELAXED, __HIP_MEMORY_SCOPE_WORKGROUP); } while (0)
#define IX_GROUP(B, GG) do { const int key = 32 * (GG) + r; const int boff = 8 * key; \
                _Pragma("unroll") for (int pj = 0; pj < 2; ++pj) { f32x16 accA, accB; \
                    _Pragma("unroll") for (int t = 0; t < 16; ++t) { accA[t] = 0.f; accB[t] = 0.f; } \
                    __builtin_amdgcn_sched_barrier(0); \
                    _Pragma("unroll") for (int s = 0; s < 4; ++s) { accA = __builtin_amdgcn_mfma_f32_32x32x16_bf16(af[2 * pj][s], B[s], accA, 0, 0, 0); \
                        accB = __builtin_amdgcn_mfma_f32_32x32x16_bf16(af[2 * pj + 1][s], B[s], accB, 0, 0, 0); } \
                    asm volatile("" : "+v"(accA), "+v"(accB)); \
                    __builtin_amdgcn_sched_barrier(0); \
                    IX_VALU_(accA, 2 * pj); IX_VALU_(accB, 2 * pj + 1); } } while (0)
            bf16x8 b0[4], b1[4];
            int g = wave;
            if (g < ng) {
                IX_LOADB(b0, g);
                for (;;) {
                    IX_LOADB(b1, g + 8);
                    IX_GROUP(b0, g);
                    g += 8; if (g >= ng) break;
                    IX_LOADB(b0, g + 8);
                    IX_GROUP(b1, g);
                    g += 8; if (g >= ng) break;
                }
            }
#undef IX_LOADB
#undef IX_GROUP
#undef IX_VALU_
        }
        __syncthreads();
        int m0t = __builtin_amdgcn_readfirstlane(m0); asm volatile("" : "+s"(m0t));
        {
            const v4u hv = *(const LAS v4u*)(hist + wave * 256 + 4 * lane);
            unsigned v = hv.x + hv.y + hv.z + hv.w;
#pragma unroll
            for (int off = 1; off < 64; off <<= 1) { const unsigned t = __shfl_down(v, off); if (lane + off < 64) v += t; }
            const unsigned long long bal = __ballot(v >= 256u);
            const int ls = 63 - __builtin_clzll(bal);
            unsigned above = __shfl_down(v, 1); if (lane == 63) above = 0u;
            if (lane == ls) { unsigned run = above; int bs, need;
                if (run + hv.w >= 256u) { bs = 3; need = 256 - (int)run; }
                else { run += hv.w; if (run + hv.z >= 256u) { bs = 2; need = 256 - (int)run; }
                    else { run += hv.z; if (run + hv.y >= 256u) { bs = 1; need = 256 - (int)run; } else { run += hv.y; bs = 0; need = 256 - (int)run; } } }
                ctl[wave] = 4 * lane + bs; ctl[8 + wave] = need; }
        }
        __syncthreads();
        for (int rp = 0; rp < IXP_TAIL; ++rp) {
            if (rp > 0) { __syncthreads(); if (tid < 8) ctl[16 + tid] = 0; __syncthreads(); }
            {
                int bsv[8];
#pragma unroll
                for (int q = 0; q < 8; ++q) bsv[q] = __builtin_amdgcn_readfirstlane(ctl[q]);
                const int ng64 = L >> 6;
                unsigned long long* mbase = (unsigned long long*)(MASK + (size_t)(m0t + (lane & 7)) * 512);
                for (int kg = wave; kg < ng64; kg += NWAVES) { const int key = 64 * kg + lane;
                    const v2u b8 = *(const LAS v2u*)(bins + 8 * key);
                    unsigned long long mine = 0ull; unsigned eq = 0u;
#pragma unroll
                    for (int q = 0; q < 8; ++q) { const int bq = (int)(((q < 4 ? b8.x : b8.y) >> (8 * (q & 3))) & 255u);
                        const unsigned long long m64 = __ballot(bq > bsv[q]);
                        mine = (lane == q) ? m64 : mine; eq |= (bq == bsv[q]) ? (1u << q) : 0u; }
                    if (lane < 8) mbase[kg] = mine;
                    while (eq) { const int q = __builtin_ctz(eq); eq &= eq - 1u;
                        const int p = __hip_atomic_fetch_add(&ctl[16 + q], 1, __ATOMIC_RELAXED, __HIP_MEMORY_SCOPE_WORKGROUP); if (p < IX_CAP) ckeys[q * IX_CAP + p] = (unsigned short)key; } }
                for (int w = tid; w < 8 * 256; w += NTHR) { const int q = w >> 8, kgz = w & 255; if (kgz >= ng64) ((unsigned long long*)(MASK + (size_t)(m0t + q) * 512))[kgz] = 0ull; }
            }
            asm volatile("s_waitcnt vmcnt(0) lgkmcnt(0)" ::: "memory");
            __syncthreads();
            const int q = wave;
            int n = ctl[16 + q]; n = n > IX_CAP ? IX_CAP : n; const int need = ctl[8 + q];
            const float* wrow = TAIL + (size_t)(m0t + q) * 128 + 64;
            const LAS unsigned char* qrow = qst + q * 2048;
            { const int c16 = lane & 15, kq = lane >> 4;
                const bf16x8 qa0 = *(const LAS bf16x8*)(qrow + (c16 * 64 + 8 * kq) * 2), qa1 = *(const LAS bf16x8*)(qrow + (c16 * 64 + 32 + 8 * kq) * 2);
                const f32x4 wq = *(const f32x4*)(wrow + 4 * kq);
                const float w0 = wq[0] * 0.03125f, w1 = wq[1] * 0.03125f, w2 = wq[2] * 0.03125f, w3 = wq[3] * 0.03125f;
                for (int base = 0; base < n; base += 32) {
                    const int i0 = base + c16, i1 = base + 16 + c16;
                    const int key0 = (i0 < n) ? (int)ckeys[q * IX_CAP + i0] : 0, key1 = (i1 < n) ? (int)ckeys[q * IX_CAP + i1] : 0;
                    const bf16* kp0 = IKB + ((size_t)((key0 >> 5) * 4 + (kq >> 1)) * 64 + (kq & 1) * 32 + (key0 & 31)) * 8;
                    const bf16* kp1 = IKB + ((size_t)((key1 >> 5) * 4 + (kq >> 1)) * 64 + (kq & 1) * 32 + (key1 & 31)) * 8;
                    const bf16x8 k00 = *(const bf16x8*)kp0, k01 = *(const bf16x8*)(kp0 + 2 * 64 * 8), k10 = *(const bf16x8*)kp1, k11 = *(const bf16x8*)(kp1 + 2 * 64 * 8);
                    f32x4h x0 = {0.f, 0.f, 0.f, 0.f}, x1 = {0.f, 0.f, 0.f, 0.f};
                    x0 = __builtin_amdgcn_mfma_f32_16x16x32_bf16(qa0, k00, x0, 0, 0, 0); x0 = __builtin_amdgcn_mfma_f32_16x16x32_bf16(qa1, k01, x0, 0, 0, 0);
                    x1 = __builtin_amdgcn_mfma_f32_16x16x32_bf16(qa0, k10, x1, 0, 0, 0); x1 = __builtin_amdgcn_mfma_f32_16x16x32_bf16(qa1, k11, x1, 0, 0, 0);
                    float sv0 = fmaf(fmaxf(x0[3], 0.f), w3, fmaf(fmaxf(x0[2], 0.f), w2, fmaf(fmaxf(x0[1], 0.f), w1, fmaxf(x0[0], 0.f) * w0)));
                    float sv1 = fmaf(fmaxf(x1[3], 0.f), w3, fmaf(fmaxf(x1[2], 0.f), w2, fmaf(fmaxf(x1[1], 0.f), w1, fmaxf(x1[0], 0.f) * w0)));
                    sv0 += __shfl_xor(sv0, 16); sv1 += __shfl_xor(sv1, 16); sv0 += __shfl_xor(sv0, 32); sv1 += __shfl_xor(sv1, 32);
                    if (kq == 0) { if (i0 < n) cscore[q * IX_CAP + i0] = sv0; if (i1 < n) cscore[q * IX_CAP + i1] = sv1; } } }
            asm volatile("s_waitcnt lgkmcnt(0)" ::: "memory");
            if (rp == IXP_TAIL - 1 && j + 1 < rounds) {
                const int un = ((j + 1) & 1) ? ((j + 1) * G + (G - 1 - bx)) : ((j + 1) * G + bx);
                if (un < NU) { IX_LOADA(8 * un); loaded = un; } }
            for (int base = 0; base < n; base += 64) { const int i = base + lane; const bool valid = i < n;
                const int ki = valid ? (int)ckeys[q * IX_CAP + i] : 0; const float si = valid ? cscore[q * IX_CAP + i] : 0.f; int rank = 0;
                for (int jj = 0; jj < n; ++jj) { const int kj = ckeys[q * IX_CAP + jj]; const float sj = cscore[q * IX_CAP + jj]; rank += (sj > si || (sj == si && kj < ki)) ? 1 : 0; }
                if (valid && rank < need) atomicOr(MASK + (size_t)(m0t + q) * 512 + (ki >> 5), 1u << (ki & 31)); }
        }
        __syncthreads();
    }
#undef IX_LOADA
}

typedef int v8i_t __attribute__((ext_vector_type(8)));
typedef int v4i_t __attribute__((ext_vector_type(4)));
__device__ __forceinline__ v8i_t frag8(const LAS unsigned char* p) { const v4i_t a = *(const LAS v4i_t*)p, b = *(const LAS v4i_t*)(p + 1024); return (v8i_t){a[0], a[1], a[2], a[3], b[0], b[1], b[2], b[3]}; }
__device__ __forceinline__ void attn_phase(const Args& a, LAS unsigned char* lds, int tid, int wave, int lane) {
    const bf16* Q = (const bf16*)(a.ws + WS_PROJ + PB_Q * PROJ_STRIDE); const unsigned char* K8 = (const unsigned char*)(a.ws + WS_KF);
    const bf16* AG = (const bf16*)(a.ws + WS_PROJ + PB_AG * PROJ_STRIDE); const unsigned char* V8 = (const unsigned char*)(a.ws + WS_VT);
    const unsigned* MASK = (const unsigned*)(a.ws + WS_MASK); bf16* MIX = (bf16*)(a.ws + WS_H);
    const int qi = lane & 31, hi = lane >> 5;
    constexpr int SC1 = 0x7f7f7f7f;
    constexpr float POFF = 6.0f;
    LAS unsigned* lut = (LAS unsigned*)(lds + 32768);
    if (tid < 16) lut[tid] = ((tid & 1) ? 0xffu : 0u) | ((tid & 2) ? 0xff00u : 0u) | ((tid & 4) ? 0xff0000u : 0u) | ((tid & 8) ? 0xff000000u : 0u);
    __syncthreads();
    for (int it = blockIdx.x; it < 512; it += gridDim.x) {
        const int hd = it & 7, kk = it >> 3; const int qb = (kk < 32) ? kk : (95 - kk);
        const int q0 = 256 * qb + 32 * wave; const int Lw = 64 * ((q0 >> 6) + 1); const int nT = 4 * (qb + 1);
        v8i_t bq[2];
#pragma unroll
        for (int ks = 0; ks < 2; ++ks) { const v4u* qp = (const v4u*)(Q + (size_t)(q0 + qi) * 1024 + hd * 128 + 64 * ks + 32 * hi);
#pragma unroll
            for (int c4 = 0; c4 < 4; ++c4) { float f[8]; unpack8(qp[c4], f); int t_;
                t_ = __builtin_amdgcn_cvt_pk_fp8_f32(f[0], f[1], 0, false); t_ = __builtin_amdgcn_cvt_pk_fp8_f32(f[2], f[3], t_, true); bq[ks][2 * c4] = t_;
                t_ = __builtin_amdgcn_cvt_pk_fp8_f32(f[4], f[5], 0, false); t_ = __builtin_amdgcn_cvt_pk_fp8_f32(f[6], f[7], t_, true); bq[ks][2 * c4 + 1] = t_; } }
        f32x16 o[4];
#pragma unroll
        for (int db = 0; db < 4; ++db)
#pragma unroll
            for (int t = 0; t < 16; ++t) o[db][t] = 0.f;
        f32x16 osum, cneg;
#pragma unroll
        for (int t = 0; t < 16; ++t) { osum[t] = 0.f; cneg[t] = 60.5f - 4.0f * POFF; }
        asm volatile("" : "+v"(cneg));
        const v8i_t ones8 = {0x38383838, 0x38383838, 0x38383838, 0x38383838, 0x38383838, 0x38383838, 0x38383838, 0x38383838};
        const unsigned long long* mrow8 = (const unsigned long long*)(MASK + (size_t)(q0 + qi) * 512);
        const v4u* kg = (const v4u*)(K8 + (size_t)hd * 512 * 4096) + tid;
        const v4u* vg = (const v4u*)(V8 + (size_t)hd * 256 * 8192) + tid;
#define AT_ITER(T_, RK, RV, MWC) do { const int Tc = (T_); \
            LAS unsigned char* buf = lds + (Tc & 1) * 16384; \
            *(LAS v4u*)(buf + tid * 16) = RK; *(LAS v4u*)(buf + 8192 + tid * 16) = RV; \
            const unsigned long long mw = MWC; \
            __syncthreads(); \
            if (Tc + 2 < nT) { RK = kg[(Tc + 2) * 512]; RV = vg[(Tc + 2) * 512]; MWC = mrow8[Tc + 2]; } \
            if (64 * Tc < Lw) { \
                f32x16 S[2]; \
                _Pragma("unroll") for (int st = 0; st < 2; ++st) { const LAS unsigned char* kb = buf + st * 4096 + lane * 16; \
                    f32x16 c0 = __builtin_amdgcn_mfma_scale_f32_32x32x64_f8f6f4(frag8(kb), bq[0], cneg, 0, 0, 0, SC1, 0, SC1); \
                    S[st] = __builtin_amdgcn_mfma_scale_f32_32x32x64_f8f6f4(frag8(kb + 2048), bq[1], c0, 0, 0, 0, SC1, 0, SC1); } \
                v8i_t pb; \
                _Pragma("unroll") for (int st = 0; st < 2; ++st) { \
                    const unsigned mw32 = st ? (unsigned)(mw >> 32) : (unsigned)mw; \
                      \
                      \
                    const unsigned mwh = mw32 >> (8 * hi); \
                    _Pragma("unroll") for (int i4 = 0; i4 < 4; ++i4) { unsigned t_ = __builtin_amdgcn_cvt_pk_u8_f32(S[st][4 * i4], 0u, 0u); t_ = __builtin_amdgcn_cvt_pk_u8_f32(S[st][4 * i4 + 1], 1u, t_); \
                        t_ = __builtin_amdgcn_cvt_pk_u8_f32(S[st][4 * i4 + 2], 2u, t_); t_ = __builtin_amdgcn_cvt_pk_u8_f32(S[st][4 * i4 + 3], 3u, t_); \
                        const unsigned nib_ = __builtin_amdgcn_ubfe(mwh, 4 * (i4 & 1) + 16 * (i4 >> 1), 4); \
                        pb[4 * st + i4] = (int)(t_ & lut[nib_]); } \
                } \
                _Pragma("unroll") for (int db = 0; db < 4; ++db) o[db] = __builtin_amdgcn_mfma_scale_f32_32x32x64_f8f6f4(frag8(buf + 8192 + db * 2048 + lane * 16), pb, o[db], 0, 1, 0, SC1, 0, SC1); \
                osum = __builtin_amdgcn_mfma_scale_f32_32x32x64_f8f6f4(ones8, pb, osum, 0, 1, 0, SC1, 0, SC1); \
            } } while (0)
        v4u rkA = kg[0], rvA = vg[0], rkB = kg[512], rvB = vg[512];
        unsigned long long mwA = mrow8[0], mwB = mrow8[1];
        for (int T = 0; T < nT; T += 2) { AT_ITER(T, rkA, rvA, mwA); AT_ITER(T + 1, rkB, rvB, mwB); }
#undef AT_ITER
        const float inv = osum[0] > 0.f ? 1.0f / osum[0] : 0.f;
        const size_t m = (size_t)(q0 + qi);
#pragma unroll
        for (int db = 0; db < 4; ++db)
#pragma unroll
            for (int tq = 0; tq < 4; tq += 2) { v2u pk[2];
#pragma unroll
                for (int k2 = 0; k2 < 2; ++k2) { const int d0 = hd * 128 + 32 * db + 8 * (tq + k2) + 4 * hi; const int t0_ = 4 * (tq + k2);
                    const v2u g = *(const v2u*)(AG + m * 1024 + d0);
                    const float y0 = o[db][t0_ + 0] * inv * siluf_(bflo(g.x)), y1 = o[db][t0_ + 1] * inv * siluf_(bfhi(g.x));
                    const float y2 = o[db][t0_ + 2] * inv * siluf_(bflo(g.y)), y3 = o[db][t0_ + 3] * inv * siluf_(bfhi(g.y));
                    pk[k2].x = pk2(y0, y1); pk[k2].y = pk2(y2, y3); }
                auto rx = __builtin_amdgcn_permlane32_swap(pk[0].x, pk[1].x, false, false); auto ry = __builtin_amdgcn_permlane32_swap(pk[0].y, pk[1].y, false, false);
                v4u w; w.x = rx[0]; w.y = ry[0]; w.z = rx[1]; w.w = ry[1];
                *(v4u*)(MIX + m * DM + hd * 128 + 32 * db + 8 * tq + 8 * hi) = w; }
    }
}

constexpr int G8_RS = 144, G8_OP = 256 * G8_RS, G8_STAGE = 2 * G8_OP;
static_assert(2 * 65536 <= LDS_BARST, "fp8 GEMM LDS");
__device__ __forceinline__ v8i_t g8_frag2(const LAS unsigned char* rowp, int xa, int xb) { const v4i_t a = *(const LAS v4i_t*)(rowp + xa), b = *(const LAS v4i_t*)(rowp + xb); return (v8i_t){a[0], a[1], a[2], a[3], b[0], b[1], b[2], b[3]}; }
__device__ __forceinline__ v8i_t g8_frag(const LAS unsigned char* p) { const v4i_t a = *(const LAS v4i_t*)p, b = *(const LAS v4i_t*)(p + 16); return (v8i_t){a[0], a[1], a[2], a[3], b[0], b[1], b[2], b[3]}; }
template <bool VT>
__device__ __forceinline__ void g8_phase(const Args& a, LAS unsigned char* lds, int tid, int wave, int lane) {
    const unsigned char* H8 = (const unsigned char*)(a.ws + WS_H8); const unsigned char* W8 = (const unsigned char*)(a.ws + WS_W8);
    bf16* PROJ = (bf16*)(a.ws + WS_PROJ); unsigned char* V8 = (unsigned char*)(a.ws + WS_VT);
    const int r = lane & 31, hi = lane >> 5, wr = wave >> 2, wc = wave & 3;
    constexpr int SC1 = 0x7f7f7f7f, SCW = 0x7a7a7a7a;
    const int srow = (tid >> 3) & 63;
    const int soff0 = srow * DM + (((lane & 7) ^ (4 * (wave & 1) + (lane >> 4))) << 4);
#define G8_SOFF(i) (soff0 + ((i) & 3) * 64 * DM)
#define G8_ISSUE(KS, ST) do { LAS unsigned char* sb_ = lds + (ST) * 65536 + wave * 1024; _Pragma("unroll") for (int i = 0; i < 8; ++i) \
        __builtin_amdgcn_global_load_lds((const unsigned*)((i < 4 ? Ag : Bg) + G8_SOFF(i) + 128 * (KS)), (LAS unsigned*)(sb_ + (i >> 2) * 32768 + (i & 3) * 8192), 16, 0, 0); } while (0)
    const int xo0 = ((2 * hi) ^ ((r >> 1) & 7)) << 4;
    const bool bal = VT && gridDim.x == 256;
    const int nti = (VT ? 4 : 12) * (SEQ / 256);
    for (int k0 = 0; ; ++k0) {
        int it;
        if (bal) { const int w = (int)blockIdx.x; if (w < 64 || k0 > 1 || (k0 == 1 && w >= 128)) break; it = (k0 == 0) ? (w - 64) : (192 + w - 64); }
        else { it = (int)blockIdx.x + k0 * (int)gridDim.x; if (it >= nti) break; }
        const int pm = it & 63; int pn = it >> 6; if (VT) pn += 8; else if (pn >= 8) pn += 4;
        const unsigned char* Ag = H8 + (size_t)(256 * pm) * DM; const unsigned char* Bg = W8 + (size_t)(256 * pn) * DM;
        constexpr bool vt = VT;
        f32x16 acc[4][2];
#pragma unroll
        for (int mt = 0; mt < 4; ++mt)
#pragma unroll
            for (int nt = 0; nt < 2; ++nt)
#pragma unroll
                for (int t = 0; t < 16; ++t) acc[mt][nt][t] = 0.f;
        G8_ISSUE(0, 0);
        for (int ks = 0; ks < DM / 128; ++ks) {
            asm volatile("s_waitcnt vmcnt(0) lgkmcnt(0)" ::: "memory"); __builtin_amdgcn_s_barrier();
            if (ks + 1 < DM / 128) G8_ISSUE(ks + 1, (ks + 1) & 1);
            const LAS unsigned char* buf = lds + (ks & 1) * 65536;
            const LAS unsigned char* tokp = buf + (128 * wr + r) * 128;
            const LAS unsigned char* wgtp = buf + 32768 + (64 * wc + r) * 128;
#pragma unroll
            for (int kk = 0; kk < 2; ++kk) { const int xa = xo0 ^ (64 * kk), xb = xa ^ 16;
                v8i_t fw[2];
#pragma unroll
                for (int nt = 0; nt < 2; ++nt) fw[nt] = g8_frag2(wgtp + nt * 32 * 128, xa, xb);
#pragma unroll
                for (int mt = 0; mt < 4; ++mt) { const v8i_t ft = g8_frag2(tokp + mt * 32 * 128, xa, xb);
                    if (vt) {
#pragma unroll
                        for (int nt = 0; nt < 2; ++nt) acc[mt][nt] = __builtin_amdgcn_mfma_scale_f32_32x32x64_f8f6f4(ft, fw[nt], acc[mt][nt], 0, 0, 0, SC1, 0, SCW);
                    } else {
#pragma unroll
                        for (int nt = 0; nt < 2; ++nt) acc[mt][nt] = __builtin_amdgcn_mfma_scale_f32_32x32x64_f8f6f4(fw[nt], ft, acc[mt][nt], 0, 0, 0, SCW, 0, SC1);
                    } }
            }
        }
        if (vt) {
#pragma unroll
            for (int nt = 0; nt < 2; ++nt) { const int R = 256 * (pn - 8) + 64 * wc + 32 * nt + r; const int hd = R >> 7, db = (R & 127) >> 5;
#pragma unroll
                for (int mt = 0; mt < 4; ++mt) { const int blk = 4 * pm + 2 * wr + (mt >> 1);
                    unsigned char* base = V8 + ((((size_t)(hd * 256 + blk) * 4 + db) * 2 + (mt & 1)) * 64 + r) * 16 + 4 * hi;
#pragma unroll
                    for (int tq = 0; tq < 4; ++tq) { int t_ = __builtin_amdgcn_cvt_pk_fp8_f32(acc[mt][nt][4 * tq], acc[mt][nt][4 * tq + 1], 0, false); t_ = __builtin_amdgcn_cvt_pk_fp8_f32(acc[mt][nt][4 * tq + 2], acc[mt][nt][4 * tq + 3], t_, true);
                        *(unsigned*)(base + (tq & 1) * 32 * 16 + 8 * (tq >> 1)) = (unsigned)t_; } } }
        } else {
            const int bufi = pn < 4 ? PB_Q : (pn < 8 ? PB_K : PB_AG);
            bf16* ob = PROJ + (size_t)bufi * (PROJ_STRIDE / 2) + 256 * (pn & 3) + 64 * wc + 8 * hi;
#pragma unroll
            for (int mt = 0; mt < 4; ++mt) { bf16* orow = ob + (size_t)(256 * pm + 128 * wr + 32 * mt + r) * 1024;
#pragma unroll
                for (int nt = 0; nt < 2; ++nt)
#pragma unroll
                    for (int tq = 0; tq < 4; tq += 2) {
                        unsigned ax = pk2(acc[mt][nt][4 * tq], acc[mt][nt][4 * tq + 1]), ay = pk2(acc[mt][nt][4 * tq + 2], acc[mt][nt][4 * tq + 3]);
                        unsigned bx = pk2(acc[mt][nt][4 * tq + 4], acc[mt][nt][4 * tq + 5]), by = pk2(acc[mt][nt][4 * tq + 6], acc[mt][nt][4 * tq + 7]);
                        auto rx = __builtin_amdgcn_permlane32_swap(ax, bx, false, false); auto ry = __builtin_amdgcn_permlane32_swap(ay, by, false, false);
                        v4u w; w.x = rx[0]; w.y = ry[0]; w.z = rx[1]; w.w = ry[1];
                        *(v4u*)(orow + 32 * nt + 8 * tq) = w; } }
        }
        __syncthreads();
    }
}

#define XB_TMO      128
#define XB_XCNT(j)  (256  + 64 * (j))
#define XB_XSUB(j)  (1280 + 64 * (j))
#define XB_XGEN(j)  (2304 + 64 * (j))
#define XB_TOP      3328
#define XB_TOPGEN   3392
#define XCD_BAR_WORDS 3456
#define XB_SPIN_CAP (1u << 18)

__device__ __forceinline__ unsigned xb_ld(unsigned* p)              { return __hip_atomic_load(p, __ATOMIC_RELAXED, __HIP_MEMORY_SCOPE_AGENT); }
__device__ __forceinline__ unsigned xb_add(unsigned* p, unsigned v) { return __hip_atomic_fetch_add(p, v, __ATOMIC_RELAXED, __HIP_MEMORY_SCOPE_AGENT); }
__device__ __forceinline__ unsigned xb_xcc_id() { return (unsigned)__builtin_amdgcn_s_getreg((3 << 11) | 20) & 0xFu; }
#define XB_SPIN(cond, bar) do { unsigned _sp = 0; while (cond) { __builtin_amdgcn_s_sleep(1); \
    if ((++_sp & 255u) == 0u) { if (xb_ld(&(bar)[XB_TMO])) break; if (_sp > XB_SPIN_CAP) { atomicAdd(&(bar)[XB_TMO], 1u); break; } } } } while (0)

struct XcdBarrier {
    unsigned* bar; unsigned x;
    volatile LAS unsigned* st;
};

__device__ __forceinline__ XcdBarrier xcd_barrier_post(unsigned* bar, volatile LAS unsigned* st) {
    XcdBarrier b; b.bar = bar; b.x = xb_xcc_id(); b.st = st;
    if (threadIdx.x == 0) (void)xb_add(&bar[XB_XCNT(b.x)], 1u);
    return b;
}
__device__ __forceinline__ void xcd_barrier_complete(unsigned* bar, unsigned x, unsigned& nloc, unsigned& nx) {
    const unsigned G = gridDim.x * gridDim.y * gridDim.z;
    unsigned sum, cnt, mine, sp = 0u;
    for (;;) {
        sum = 0u; cnt = 0u; mine = 0u;
#pragma unroll
        for (unsigned j = 0; j < 16; ++j) { const unsigned c = xb_ld(&bar[XB_XCNT(j)]); sum += c; cnt += (c > 0u) ? 1u : 0u; mine = (j == x) ? c : mine; }
        if (sum == G) break;
        __builtin_amdgcn_s_sleep(1);
        if ((++sp & 255u) == 0u) { if (xb_ld(&bar[XB_TMO])) break; if (sp > XB_SPIN_CAP) { atomicAdd(&bar[XB_TMO], 1u); break; } }
    }
    nloc = mine > 0u ? mine : 1u; nx = cnt > 0u ? cnt : 1u;
}

__device__ __forceinline__ void xcd_barrier(const XcdBarrier& b) {
    asm volatile("s_waitcnt vmcnt(0)" ::: "memory");
    __syncthreads();
    if (threadIdx.x == 0) {
        unsigned* bar = b.bar;
        __builtin_amdgcn_s_waitcnt(0);
        unsigned nloc = b.st[0], nx = b.st[1];
        if (nloc == 0u) { xcd_barrier_complete(bar, b.x, nloc, nx); b.st[0] = nloc; b.st[1] = nx; }
        const unsigned old = xb_add(&bar[XB_XSUB(b.x)], 1u);
        const unsigned gen = old / nloc;
        if (old + 1u == (gen + 1u) * nloc) {
            __builtin_amdgcn_fence(__ATOMIC_RELEASE, "agent");
            asm volatile("s_waitcnt vmcnt(0)" ::: "memory");
            const unsigned og = xb_add(&bar[XB_TOP], 1u);
            const unsigned tg = og / nx;
            if (og + 1u == (tg + 1u) * nx) xb_add(&bar[XB_TOPGEN], 1u);
            else XB_SPIN(xb_ld(&bar[XB_TOPGEN]) == tg, bar);
            __builtin_amdgcn_fence(__ATOMIC_ACQUIRE, "agent");
            xb_add(&bar[XB_XGEN(b.x)], 1u);
            asm volatile("s_waitcnt vmcnt(0)" ::: "memory");
        } else {
            XB_SPIN(xb_ld(&bar[XB_XGEN(b.x)]) == gen, bar);
            __builtin_amdgcn_fence(__ATOMIC_ACQUIRE, "agent");
            asm volatile("s_waitcnt vmcnt(0)" ::: "memory");
        }
    }
    __syncthreads();
}

__global__ void __launch_bounds__(NTHR, 2) mk_fwd(Args a) {
    extern __shared__ __attribute__((aligned(16))) unsigned char lds_raw[];
    LAS unsigned char* lds = (LAS unsigned char*)lds_raw;
    const int tid = threadIdx.x, lane = tid & 63, wave = __builtin_amdgcn_readfirstlane(tid >> 6);
    const int lo = a.ph_lo, hi = a.ph_hi;
#define IN(k) (lo <= (k) && (k) < hi)
    if (tid < 16) ((LAS unsigned*)(lds + LDS_BARST))[tid] = 0u;
    __syncthreads();
    XcdBarrier gbar = xcd_barrier_post((unsigned*)(a.ws + WS_CTL + CTL_BAR_OFF + (size_t)a.bar_region * 16384), (volatile LAS unsigned*)(lds + LDS_BARST));
#define SEAM(k) do { if (IN(k) && IN((k) + 1)) { xcd_barrier(gbar); } } while (0)
#ifdef PROBE_SYNCS
    for (int i = 0; i < PROBE_SYNCS; ++i) xcd_barrier(gbar);
#endif
    if (IN(0)) { for (int rep = 0; rep < REP_P0; ++rep) { phase0(a, lds, tid, wave, lane, rep == 0); __syncthreads(); } }
    SEAM(0);
    if (IN(1)) { for (int rep = 0; rep < REP_P01; ++rep) phase1(a, wave, lane); }
    SEAM(1);
    if (IN(2)) for (int rep = 0; rep < REP_GEMM; ++rep) {
        {
            pg8::Gemm g{(const pg8::bf16_t*)(a.ws + WS_H), (const pg8::bf16_t*)(a.ws + WS_WIN), SEQ, NPROJ, DM}; pg8::StaticOrder S; S.init(SEQ, NPROJ, gridDim.x, (int)blockIdx.x);
            pg8::EpiProj E{(pg8::bf16_t*)(a.ws + WS_PROJ) + (size_t)PB_QI * (PROJ_STRIDE / 2), PROJ_STRIDE / 2, (float*)(a.ws + WS_TAIL)};
            pg8::gemm_phase<pg8::EpiProj, pg8::StaticOrder, true, true>(lds, g, S, E);
        }
        __syncthreads();
        g8_phase<false>(a, lds, tid, wave, lane);
        g8_phase<true>(a, lds, tid, wave, lane);
    }
    SEAM(2);
    if (IN(3)) {
        phase3_post(a, wave, lane);
        for (int rep = 0; rep < REP_HG; ++rep) for (int u = blockIdx.x; u < BH * HG_NG; u += gridDim.x) { hgrn_unit<false>(a, lds, u & 7, u >> 3, tid, wave, lane); __syncthreads(); }
    }
    SEAM(3);
    if (IN(4)) {
#ifdef MK_DUP_PHASE
        if (lo != 4)
#endif
        hgrn_scan(a, tid);
        for (int rep = 0; rep < REP_IDX; ++rep) indexer_phase(a, lds, tid, wave, lane);
    }
    SEAM(4);
    if (IN(5)) {
        for (int rep = 0; rep < REP_ATT; ++rep) attn_phase(a, lds, tid, wave, lane);
        __syncthreads();
        for (int rep = 0; rep < REP_HG; ++rep) for (int u = blockIdx.x; u < BH * HG_NG; u += gridDim.x) { hgrn_unit<true>(a, lds, u & 7, u >> 3, tid, wave, lane); __syncthreads(); }
    }
    SEAM(5);
    if (IN(6)) for (int rep = 0; rep < REP_OUT; ++rep) {
        pg8::Gemm g{(const pg8::bf16_t*)(a.ws + WS_H), (const pg8::bf16_t*)(a.ws + WS_WOUT), SEQ, DM, DM}; pg8::StaticOrder S; S.init(SEQ, DM, gridDim.x, (int)blockIdx.x);
        pg8::EpiOut E{a.x, (const float*)(a.ws + WS_CTL) + 2 * DM, a.out, DM};
        pg8::gemm_phase<pg8::EpiOut, pg8::StaticOrder, true, true>(lds, g, S, E);
    }
#undef IN
#undef SEAM
}

extern "C" void kernel_launch(void* const* d_in, const int* in_sizes, int n_in, void* d_out, int out_size, void* d_ws, size_t ws_size, hipStream_t stream) {
    static int grid = 0;
    if (grid == 0) {
        int dev = 0, cus = 0, per_cu = 0;
        if (n_in != 13 || out_size != SEQ * DM || ws_size < WS_END) { fprintf(stderr, "kernel_launch: unexpected shapes (n_in %d out %d ws %zu)\n", n_in, out_size, ws_size); grid = -1; return; }
        hipGetDevice(&dev); hipDeviceGetAttribute(&cus, hipDeviceAttributeMultiprocessorCount, dev);
        hipFuncSetAttribute((const void*)mk_fwd, hipFuncAttributeMaxDynamicSharedMemorySize, LDS_BYTES);
        hipOccupancyMaxActiveBlocksPerMultiprocessor(&per_cu, (const void*)mk_fwd, NTHR, LDS_BYTES);
        if (per_cu < 1) { fprintf(stderr, "kernel_launch: occupancy query says %d blocks per CU\n", per_cu); per_cu = 1; }
        (void)hipGetLastError();
        grid = cus;
    }
    if (grid < 0) return;
    hipMemsetAsync((char*)d_ws + WS_CTL, 0, CTL_ZERO_BYTES, stream);
    Args a;
    memset(&a, 0, sizeof(a));
    a.x = (const float*)d_in[0]; a.c = (const float*)d_in[1]; a.pos = (const int*)d_in[2]; a.ada_w = (const float*)d_in[3]; a.ada_b = (const float*)d_in[4];
    a.norm_g = (const float*)d_in[5]; a.w_in = (const float*)d_in[6]; a.q_norm_g = (const float*)d_in[7]; a.k_norm_g = (const float*)d_in[8]; a.ik_norm_g = (const float*)d_in[9];
    a.lb_logits = (const float*)d_in[10]; a.hgrn_norm_g = (const float*)d_in[11]; a.w_out = (const float*)d_in[12];
    a.out = (float*)d_out; a.ws = (unsigned char*)d_ws;
    for (int d = 0; d < 64; ++d) a.invf_a[d] = (float)std::pow(10000.0, -(double)d / 64.0);
    for (int d = 0; d < 32; ++d) a.invf_i[d] = (float)std::pow(10000.0, -(double)d / 32.0);
#if MK_N_LAUNCHES == 1
#ifdef MK_DUP_PHASE
    {
        void* args[] = {&a};
        a.ph_lo = 0; a.ph_hi = MK_DUP_PHASE + 1;
        (void)hipLaunchCooperativeKernel((const void*)mk_fwd, dim3(grid), dim3(NTHR), args, LDS_BYTES, stream);
        a.ph_lo = MK_DUP_PHASE; a.ph_hi = N_PHASES; a.bar_region = 1;
        (void)hipLaunchCooperativeKernel((const void*)mk_fwd, dim3(grid), dim3(NTHR), args, LDS_BYTES, stream);
    }
#else
    a.ph_lo = 0; a.ph_hi = N_PHASES;
    void* args[] = {&a};
    hipError_t e = hipLaunchCooperativeKernel((const void*)mk_fwd, dim3(grid), dim3(NTHR), args, LDS_BYTES, stream);
    if (e != hipSuccess) fprintf(stderr, "kernel_launch: cooperative launch failed: %s (grid %d)\n", hipGetErrorString(e), grid);
#endif
#else
    for (int p = 0; p < N_PHASES; ++p) { a.ph_lo = p; a.ph_hi = p + 1; hipLaunchKernelGGL(mk_fwd, dim3(grid), dim3(NTHR), LDS_BYTES, stream, a); }
#endif
}
```
